# Optimizing an MI355X kernel written in HIP

```python
import math
import jax, jax.numpy as jnp
from jax import lax
import numpy as np

D_MODEL = 1024
BATCH = 2
SEQ = 8192
DEPTH = 2

N_META = 16
CHUNK = 64
PAD = CHUNK - N_META
CONV_K = 4
RET_HEADS = 4
RET_DK = D_MODEL // 8
RET_DV = D_MODEL // 4
RET_QK = RET_HEADS * RET_DK
RET_VW = RET_HEADS * RET_DV
ROPE_BASE = 10000.0
GDN_HEADS = 4
GDN_DK = D_MODEL // 8
GDN_DV = D_MODEL // 4
GDN_QK = GDN_HEADS * GDN_DK
GDN_VW = GDN_HEADS * GDN_DV
AB_SIZES = (RET_QK, RET_QK, RET_VW, RET_VW, GDN_QK, GDN_QK, GDN_VW, GDN_HEADS, GDN_HEADS, GDN_VW)
AB_IN = 2 * RET_QK + 2 * RET_VW + 2 * GDN_QK + 2 * GDN_VW + 2 * GDN_HEADS
AB_OUT = RET_VW + GDN_VW
SSD_DINNER = 2 * D_MODEL
SSD_HEADDIM = 64
SSD_HEADS = SSD_DINNER // SSD_HEADDIM
SSD_GROUPS = 4
SSD_HPG = SSD_HEADS // SSD_GROUPS
SSD_DSTATE = 128
SSD_GN = SSD_GROUPS * SSD_DSTATE
SSD_CONV_CH = SSD_DINNER + 2 * SSD_GN
SSD_IN = SSD_DINNER + SSD_CONV_CH + SSD_HEADS
D_FF = 4 * D_MODEL
DN_ALPHA = (2 * DEPTH) ** 0.25
DN_BETA = (8 * DEPTH) ** -0.25
N_AB = (DEPTH + 1) // 2
N_C = DEPTH // 2
LN_EPS = 1e-5
GN_EPS = 1e-5
RMS_EPS = 1e-6

kernel_name = 'hybrid_retnet_gdn_mamba2_deepnorm'


def split_cols(a, sizes):
    offs, acc = [], 0
    for s in sizes[:-1]:
        acc += s
        offs.append(acc)
    return jnp.split(a, offs, axis=-1)


def _standardize(x, eps):
    xf = x.astype(jnp.float32)
    xc = xf - jnp.mean(xf, -1, keepdims=True)
    return xc * lax.rsqrt(jnp.mean(xc * xc, -1, keepdims=True) + eps)


def _rms(x, eps):
    xf = x.astype(jnp.float32)
    return xf * lax.rsqrt(jnp.mean(xf * xf, -1, keepdims=True) + eps)


def layer_norm(x, w, b):
    return (_standardize(x, LN_EPS) * w + b).astype(x.dtype)


def l2norm(x):
    xf = x.astype(jnp.float32)
    return xf * lax.rsqrt(jnp.sum(xf * xf, -1, keepdims=True) + 1e-6)


def rope(x, cos, sin):
    x1, x2 = jnp.split(x.astype(jnp.float32), 2, axis=-1)
    return jnp.concatenate([x1 * cos - x2 * sin, x1 * sin + x2 * cos], axis=-1)


def causal_dwconv(x, w):
    L = x.shape[1]
    xp = jnp.pad(x, ((0, 0), (CONV_K - 1, 0), (0, 0)))
    return sum(xp[:, k:k + L] * w[k] for k in range(CONV_K))


def to_chunks(a):
    a = jnp.pad(a, [(0, 0), (PAD, 0)] + [(0, 0)] * (a.ndim - 2))
    nc = a.shape[1] // CHUNK
    a = a.reshape((a.shape[0], nc, CHUNK) + a.shape[2:])
    return jnp.moveaxis(a, 1, 0)


def from_chunks(o):
    o = jnp.moveaxis(o, 0, 1)
    o = o.reshape((o.shape[0], -1) + o.shape[3:])
    return o[:, PAD:]


def chunked_decay_attention(q, k, v, g):
    B, _, G, dk = q.shape
    Hg, dv = v.shape[-2:]
    xs = tuple(to_chunks(a.astype(jnp.float32)) for a in (q, k, v, g))
    incl = jnp.tril(jnp.ones((CHUNK, CHUNK), bool))[None, :, :, None, None]

    def body(S, inp):
        qc, kc, vc, gc = inp
        gcum = jnp.cumsum(gc, axis=1)
        seg = gcum[:, :, None] - gcum[:, None]
        att = jnp.einsum('btgd,bsgd->btsg', qc, kc)[..., None] * jnp.exp(jnp.where(incl, seg, -jnp.inf))
        o = jnp.einsum('btsgh,bsghv->btghv', att, vc)
        o = o + jnp.einsum('btgd,bghdv->btghv', qc, S) * jnp.exp(gcum)[..., None]
        g_last = gcum[:, -1]
        S = S * jnp.exp(g_last)[..., None, None] + jnp.einsum(
            'bsgd,bsghv->bghdv', kc, vc * jnp.exp(g_last[:, None] - gcum)[..., None])
        return S, o

    S0 = jnp.zeros((B, G, Hg, dk, dv), jnp.float32)
    _, o = lax.scan(body, S0, xs)
    return from_chunks(o)


def chunked_gated_delta_rule(q, k, v, beta, g):
    B, _, H, dk = q.shape
    dv = v.shape[-1]
    xs = tuple(to_chunks(a.astype(jnp.float32)) for a in (q, k, v, beta, g))
    eye = jnp.eye(CHUNK, dtype=jnp.float32)
    strict = jnp.tril(jnp.ones((CHUNK, CHUNK), bool), -1)
    incl = jnp.tril(jnp.ones((CHUNK, CHUNK), bool))

    def body(S, inp):
        qc, kc, vc, bc, gc = (jnp.moveaxis(a, 1, 2) for a in inp)
        gcum = jnp.cumsum(gc, axis=-1)
        seg = gcum[..., :, None] - gcum[..., None, :]
        kb = kc * bc[..., None]
        A = jnp.einsum('bhtd,bhsd->bhts', kb, kc) * jnp.exp(jnp.where(strict, seg, -jnp.inf))
        rhs = jnp.concatenate([vc * bc[..., None], kb * jnp.exp(gcum)[..., None]], axis=-1)
        u = lax.linalg.triangular_solve(eye + A, rhs, left_side=True, lower=True)
        w_v, w_k = u[..., :dv], u[..., dv:]
        v_new = w_v - jnp.einsum('bhcd,bhdv->bhcv', w_k, S)
        att = jnp.einsum('bhtd,bhsd->bhts', qc, kc) * jnp.exp(jnp.where(incl, seg, -jnp.inf))
        o = jnp.einsum('bhtd,bhdv->bhtv', qc * jnp.exp(gcum)[..., None], S) + jnp.einsum('bhts,bhsv->bhtv', att, v_new)
        g_last = gcum[..., -1:]
        S = S * jnp.exp(g_last)[..., None] + jnp.einsum(
            'bhsd,bhsv->bhdv', kc * jnp.exp(g_last - gcum)[..., None], v_new)
        return S, jnp.moveaxis(o, 1, 2)

    S0 = jnp.zeros((B, H, dk, dv), jnp.float32)
    _, o = lax.scan(body, S0, xs)
    return from_chunks(o)


def retention_gdn_mixer(h, w_in, ret_gn_w, conv_q, conv_k, conv_v, A_log, dt_bias, gdn_norm_w, w_out, cos, sin):
    B, L, _ = h.shape
    rq, rk, rv, rg, gq, gk, gv, gb, ga, gg = split_cols(h @ w_in, AB_SIZES)
    rq = rope(rq.reshape(B, L, RET_HEADS, RET_DK), cos, sin) * RET_DK ** -0.5
    rk = rope(rk.reshape(B, L, RET_HEADS, RET_DK), cos, sin)
    rv = rv.reshape(B, L, RET_HEADS, 1, RET_DV)
    log_gamma = jnp.log1p(-jnp.exp2(-5.0 - jnp.arange(RET_HEADS, dtype=jnp.float32)))
    rgam = jnp.broadcast_to(log_gamma[:, None], (B, L, RET_HEADS, 1))
    ro = chunked_decay_attention(rq, rk, rv, rgam).reshape(B, L, RET_HEADS, RET_DV)
    ro = _standardize(ro, GN_EPS).reshape(B, L, RET_VW) * ret_gn_w
    ret_out = jax.nn.silu(rg.astype(jnp.float32)) * ro
    gq = l2norm(jax.nn.silu(causal_dwconv(gq, conv_q)).reshape(B, L, GDN_HEADS, GDN_DK)) * GDN_DK ** -0.5
    gk = l2norm(jax.nn.silu(causal_dwconv(gk, conv_k)).reshape(B, L, GDN_HEADS, GDN_DK))
    gv = jax.nn.silu(causal_dwconv(gv, conv_v)).reshape(B, L, GDN_HEADS, GDN_DV)
    beta = jax.nn.sigmoid(gb.astype(jnp.float32))
    gdec = -jnp.exp(A_log.astype(jnp.float32)) * jax.nn.softplus(ga.astype(jnp.float32) + dt_bias)
    go = chunked_gated_delta_rule(gq, gk, gv, beta, gdec)
    go = (_rms(go, RMS_EPS) * gdn_norm_w).reshape(B, L, GDN_VW) * jax.nn.silu(gg.astype(jnp.float32))
    y = jnp.concatenate([ret_out, go], axis=-1).astype(h.dtype)
    return y @ w_out


def mamba2_mixer(h, w_in, conv_w, conv_b, A_log, dt_bias, D, norm_w, w_out):
    B, L, _ = h.shape
    z, xbc, dt = split_cols(h @ w_in, (SSD_DINNER, SSD_CONV_CH, SSD_HEADS))
    xbc = jax.nn.silu(causal_dwconv(xbc, conv_w) + conv_b)
    xs, Bm, Cm = split_cols(xbc, (SSD_DINNER, SSD_GN, SSD_GN))
    xs = xs.astype(jnp.float32).reshape(B, L, SSD_GROUPS, SSD_HPG, SSD_HEADDIM)
    Bm = Bm.reshape(B, L, SSD_GROUPS, SSD_DSTATE)
    Cm = Cm.reshape(B, L, SSD_GROUPS, SSD_DSTATE)
    dt = jax.nn.softplus(dt.astype(jnp.float32) + dt_bias).reshape(B, L, SSD_GROUPS, SSD_HPG)
    A = -jnp.exp(A_log.astype(jnp.float32)).reshape(SSD_GROUPS, SSD_HPG)
    y = chunked_decay_attention(Cm, Bm, xs * dt[..., None], dt * A)
    y = y + xs * D.reshape(SSD_GROUPS, SSD_HPG, 1)
    y = y.reshape(B, L, SSD_DINNER) * jax.nn.silu(z.astype(jnp.float32))
    y = _rms(y.reshape(B, L, SSD_GROUPS, SSD_DINNER // SSD_GROUPS), RMS_EPS).reshape(B, L, SSD_DINNER) * norm_w
    return y.astype(h.dtype) @ w_out


def sq_relu_mlp(h, w1, w2):
    return jnp.square(jax.nn.relu(h @ w1)) @ w2


def setup_inputs(seed: int = 0) -> dict:
    key = jax.random.key(seed)
    ks = iter(jax.random.split(key, 32))

    def nrm(shape, scale):
        return jax.random.normal(next(ks), shape, jnp.float32) * scale

    def gain(shape):
        return 1.0 + nrm(shape, 0.02)

    def dt_bias(shape):
        dt = jnp.exp(jax.random.uniform(next(ks), shape, jnp.float32, math.log(1e-3), math.log(1e-1)))
        return dt + jnp.log(-jnp.expm1(-dt))

    def a_log(shape):
        return jnp.log(jax.random.uniform(next(ks), shape, jnp.float32, 1.0, 16.0))

    return {
        'x': nrm((BATCH, SEQ, D_MODEL), 1.0),
        'meta_tokens': nrm((N_META, D_MODEL), 1.0),
        'ab_w_in': nrm((N_AB, D_MODEL, AB_IN), D_MODEL ** -0.5),
        'ab_ret_gn_w': gain((N_AB, RET_VW)),
        'ab_conv_q': nrm((N_AB, CONV_K, GDN_QK), CONV_K ** -0.5),
        'ab_conv_k': nrm((N_AB, CONV_K, GDN_QK), CONV_K ** -0.5),
        'ab_conv_v': nrm((N_AB, CONV_K, GDN_VW), CONV_K ** -0.5),
        'ab_A_log': a_log((N_AB, GDN_HEADS)),
        'ab_dt_bias': dt_bias((N_AB, GDN_HEADS)),
        'ab_gdn_norm_w': gain((N_AB, GDN_DV)),
        'ab_w_out': nrm((N_AB, AB_OUT, D_MODEL), AB_OUT ** -0.5 * DN_BETA),
        'c_w_in': nrm((N_C, D_MODEL, SSD_IN), D_MODEL ** -0.5),
        'c_conv_w': nrm((N_C, CONV_K, SSD_CONV_CH), CONV_K ** -0.5),
        'c_conv_b': nrm((N_C, SSD_CONV_CH), 0.02),
        'c_A_log': a_log((N_C, SSD_HEADS)),
        'c_dt_bias': dt_bias((N_C, SSD_HEADS)),
        'c_D': gain((N_C, SSD_HEADS)),
        'c_norm_w': gain((N_C, SSD_DINNER)),
        'c_w_out': nrm((N_C, SSD_DINNER, D_MODEL), SSD_DINNER ** -0.5 * DN_BETA),
        'mlp_w1': nrm((DEPTH, D_MODEL, D_FF), D_MODEL ** -0.5),
        'mlp_w2': nrm((DEPTH, D_FF, D_MODEL), D_FF ** -0.5 * DN_BETA),
        'ln1_w': gain((DEPTH, D_MODEL)),
        'ln1_b': nrm((DEPTH, D_MODEL), 0.02),
        'ln2_w': gain((DEPTH, D_MODEL)),
        'ln2_b': nrm((DEPTH, D_MODEL), 0.02),
    }


def reference(x, meta_tokens, ab_w_in, ab_ret_gn_w, ab_conv_q, ab_conv_k, ab_conv_v, ab_A_log, ab_dt_bias,
              ab_gdn_norm_w, ab_w_out, c_w_in, c_conv_w, c_conv_b, c_A_log, c_dt_bias, c_D, c_norm_w, c_w_out,
              mlp_w1, mlp_w2, ln1_w, ln1_b, ln2_w, ln2_b):
    B = x.shape[0]
    meta = jnp.broadcast_to(meta_tokens[None].astype(x.dtype), (B, N_META, D_MODEL))
    h = jnp.concatenate([meta, x], axis=1)
    L = h.shape[1]
    pos = jnp.arange(L, dtype=jnp.float32)
    inv_freq = 1.0 / (ROPE_BASE ** jnp.linspace(0.0, 1.0, RET_DK // 2, dtype=jnp.float32))
    ang = pos[:, None] * inv_freq[None]
    cos = jnp.cos(ang)[None, :, None, :]
    sin = jnp.sin(ang)[None, :, None, :]
    for i in range(DEPTH):
        j = i // 2
        if i % 2 == 0:
            mix = retention_gdn_mixer(h, ab_w_in[j], ab_ret_gn_w[j], ab_conv_q[j], ab_conv_k[j], ab_conv_v[j],
                                      ab_A_log[j], ab_dt_bias[j], ab_gdn_norm_w[j], ab_w_out[j], cos, sin)
        else:
            mix = mamba2_mixer(h, c_w_in[j], c_conv_w[j], c_conv_b[j], c_A_log[j], c_dt_bias[j], c_D[j],
                               c_norm_w[j], c_w_out[j])
        h = layer_norm(DN_ALPHA * h + mix, ln1_w[i], ln1_b[i])
        h = layer_norm(DN_ALPHA * h + sq_relu_mlp(h, mlp_w1[i], mlp_w2[i]), ln2_w[i], ln2_b[i])
    return h[:, N_META:]
```

```cpp
#include <hip/hip_runtime.h>
#include <hip/hip_cooperative_groups.h>
#include <cstdio>
#include <cstdint>
namespace cg = cooperative_groups;

#define LAS __attribute__((address_space(3)))
typedef unsigned short bf16_t;
typedef short bf16x8 __attribute__((ext_vector_type(8)));
typedef float f32x4 __attribute__((ext_vector_type(4)));
typedef float f32x2 __attribute__((ext_vector_type(2)));
typedef unsigned u32x4 __attribute__((ext_vector_type(4)));
typedef unsigned u32x2 __attribute__((ext_vector_type(2)));
typedef unsigned char uchar;

constexpr int DM = 1024, SEQ = 8192, MMAIN = 16384, MROWS = 16400, NCHUNK = 129, DFF = 4096;
constexpr float DN_ALPHA = 1.41421356237309515f;
constexpr int NTHREADS = 512;
#define REP1 1
#define REP0 1
#define REPT 1
#define REP2 1
#define REP3 1
#define REP8 1
#define REP11 1
#define REP12 1
constexpr int LDS_BYTES = 133120;

constexpr size_t OFF_CS = 0;
constexpr size_t OFF_SIDE = 4227072;
constexpr size_t OFF_RT = 6326272;
constexpr size_t OFF_WSM = 6391808;
constexpr size_t OFF_TINV = 6457344;
constexpr size_t OFF_HB = 14911488;
constexpr size_t OFF_Y = 48498688;
constexpr size_t OFF_P = 115673088;
constexpr size_t OFF_WA = 250021888;
constexpr size_t OFF_WOUT = OFF_WA + 12582912;
constexpr size_t WS_END = OFF_WA + 16777216 + 16384;
constexpr size_t OFF_BAR = OFF_WA + 16777216;

struct Params {
    const float* in[25];
    float* out;
    uchar* ws;
    int ph_lo, ph_hi;
};
enum { I_X = 0, I_META, I_ABWIN, I_RETGN, I_CONVQ, I_CONVK, I_CONVV, I_ABALOG, I_ABDTB, I_GDNNW, I_ABWOUT, I_CWIN, I_CCONVW, I_CCONVB, I_CALOG, I_CDTB, I_CD, I_CNORMW, I_CWOUT,
       I_W1, I_W2, I_LN1W, I_LN1B, I_LN2W, I_LN2B };

__device__ __forceinline__ float bf2f(unsigned h) { return __uint_as_float(h << 16); }
typedef __bf16 bf16x2_t __attribute__((ext_vector_type(2)));
__device__ __forceinline__ unsigned cvt_pk_bf16(float lo, float hi) { f32x2 v = {lo, hi}; bf16x2_t b = __builtin_convertvector(v, bf16x2_t); return __builtin_bit_cast(unsigned, b); }
__device__ __forceinline__ unsigned f2bf(float f) { return cvt_pk_bf16(f, 0.f) & 0xffffu; }
__device__ __forceinline__ float siluf(float x) { return x * __builtin_amdgcn_rcpf(1.f + __expf(-x)); }
__device__ __forceinline__ float softplusf(float x) { return x > 20.f ? x : log1pf(__expf(x)); }
__device__ __forceinline__ int tok_row(int b, int L) { return L < 64 ? (MMAIN + L - 48) : (b * SEQ + L - 64); }
__device__ __forceinline__ bf16x8 mk8(u32x2 lo, u32x2 hi) { u32x4 v = {lo.x, lo.y, hi.x, hi.y}; return __builtin_bit_cast(bf16x8, v); }
__device__ __forceinline__ bf16x8 pack8(f32x4 a, f32x4 b) { u32x4 v = {cvt_pk_bf16(a[0], a[1]), cvt_pk_bf16(a[2], a[3]), cvt_pk_bf16(b[0], b[1]), cvt_pk_bf16(b[2], b[3])}; return __builtin_bit_cast(bf16x8, v); }
__device__ __forceinline__ float row16_sum(float v) {
    v += __builtin_bit_cast(float, __builtin_amdgcn_update_dpp(0, __builtin_bit_cast(int, v), 0xB1, 0xF, 0xF, true));
    v += __builtin_bit_cast(float, __builtin_amdgcn_update_dpp(0, __builtin_bit_cast(int, v), 0x4E, 0xF, 0xF, true));
    v += __builtin_bit_cast(float, __builtin_amdgcn_update_dpp(0, __builtin_bit_cast(int, v), 0x141, 0xF, 0xF, true));
    v += __builtin_bit_cast(float, __builtin_amdgcn_update_dpp(0, __builtin_bit_cast(int, v), 0x140, 0xF, 0xF, true));
    return v;
}
#define MFMA16(a, b, c) __builtin_amdgcn_mfma_f32_16x16x32_bf16((a), (b), (c), 0, 0, 0)

namespace pg8 {
constexpr int BM = 256, BK = 64, HALF = 128, HTB = HALF * BK * 2, STAGE_BYTES = 8 * HTB, NXCD = 8, WGM = 8;
__host__ __device__ __forceinline__ int lds_byte(int r, int c) { const int st = (r >> 4) * 2 + (c >> 5), rr = r & 15, cc = c & 31, ob = rr * 64 + cc * 2; return st * 1024 + (ob ^ (((ob >> 9) & 1) << 5)); }
__host__ __device__ __forceinline__ void stage_rc(int b, int& R, int& C) { const int st = b / 1024, sb = b % 1024, swz = sb ^ (((sb >> 9) & 1) << 5); R = (st >> 1) * 16 + swz / 64; C = (st & 1) * 32 + (swz % 64) / 2; }
__host__ __device__ __forceinline__ int perm32(int rho) { const int n = rho >> 4, i = rho & 15; return 8 * (i >> 2) + 4 * n + (i & 3); }
struct Unit { int pm, pn; };
struct Gemm { const bf16_t* A; const bf16_t* Bt; int M, N, K; };
struct StaticOrder {
    int nM, nN, nwg, G, c;
    __device__ void init(int M, int N, int G_, int c_) { nM = M / BM; nN = N / BM; nwg = nM * nN; G = G_; c = c_; }
    __device__ bool next(int i, Unit& u) const {
        const long L = (long)i * G + c; if (L >= nwg) return false;
        int wgid = (int)L; { const int q = nwg / NXCD, r = nwg % NXCD, xcd = wgid % NXCD, off = wgid / NXCD; wgid = (xcd < r ? xcd * (q + 1) : r * (q + 1) + (xcd - r) * q) + off; }
        const int nig = WGM * nN, gid = wgid / nig, fm = gid * WGM, gsz = (nM - fm) < WGM ? (nM - fm) : WGM;
        u.pm = fm + ((wgid % nig) % gsz); u.pn = (wgid % nig) / gsz; return true;
    }
};

template <class Epi, class XB>
__device__ __forceinline__ void gemm_phase(LAS uchar* lds, const Gemm g, const StaticOrder& S, const Epi& E, const int tid, const XB& xbar) {
    const int wid = __builtin_amdgcn_readfirstlane(tid >> 6), lane = tid & 63, wr = wid >> 2, wc = wid & 3, fr = lane & 15, fq = lane >> 4;
    const int K = g.K, nt = K / BK;
    unsigned voffA[2], voffB[2];
#pragma unroll
    for (int i = 0; i < 2; ++i) { int R, C; stage_rc(tid * 16 + i * 8192, R, C); const int Rb = (R & ~31) + perm32(R & 31);
        voffA[i] = (unsigned)(R * K + C) * 2u; voffB[i] = (unsigned)(Rb * K + C) * 2u; }
    const size_t kstep = (size_t)(BK * 2);
    const size_t hstep = (size_t)HALF * K * 2;
    const size_t tstep = 2 * hstep;
    const unsigned ldsw = (unsigned)wid * 1024u;
    const int aoff = lds_byte(wr * 64 + fr, fq * 8), boff = lds_byte(wc * 32 + fr, fq * 8);
#define PG8_SA(b, h) (((b) * 2 + (h)) * HTB)
#define PG8_SB(b, h) ((4 + (b) * 2 + (h)) * HTB)
#define PG8_STAGE(bufoff, gbase, voff) do { _Pragma("unroll") for (int _i = 0; _i < 2; ++_i) \
        __builtin_amdgcn_global_load_lds((const unsigned*)((const char*)(gbase) + (voff)[_i]), (LAS unsigned*)(lds + (bufoff) + ldsw + _i * 8192), 16, 0, 0); } while (0)
#define PG8_LDA(dst, b, h) do { _Pragma("unroll") for (int m = 0; m < 4; ++m) _Pragma("unroll") for (int k = 0; k < 2; ++k) dst[m][k] = *(const LAS bf16x8*)(lds + PG8_SA(b, h) + aoff + m * 2048 + k * 1024); } while (0)
#define PG8_LDB(dst, b, h) do { _Pragma("unroll") for (int n = 0; n < 2; ++n) _Pragma("unroll") for (int k = 0; k < 2; ++k) dst[n][k] = *(const LAS bf16x8*)(lds + PG8_SB(b, h) + boff + n * 2048 + k * 1024); } while (0)
#define PG8_MMA(ai, bj, At, Bt) do { __builtin_amdgcn_s_setprio(1); _Pragma("unroll") for (int m = 0; m < 4; ++m) _Pragma("unroll") for (int n = 0; n < 2; ++n) _Pragma("unroll") for (int k = 0; k < 2; ++k) \
        acc[ai][bj][m][n] = __builtin_amdgcn_mfma_f32_16x16x32_bf16(Bt[n][k], At[m][k], acc[ai][bj][m][n], 0, 0, 0); __builtin_amdgcn_s_setprio(0); } while (0)
#define PG8_WAIT_V(n) asm volatile("s_waitcnt vmcnt(" #n ")" ::: "memory")
#define PG8_WAIT_L(n) asm volatile("s_waitcnt lgkmcnt(" #n ")" ::: "memory")
#define PG8_BAR __builtin_amdgcn_s_barrier()
#define PG8_SCHED __builtin_amdgcn_sched_barrier(0)
    Unit cur, nxt; int ui = 0;
    if (!S.next(0, cur)) return;
    f32x4 acc[2][2][4][2];
#pragma unroll
    for (int a = 0; a < 2; ++a)
#pragma unroll
        for (int b = 0; b < 2; ++b)
#pragma unroll
            for (int m = 0; m < 4; ++m)
#pragma unroll
                for (int n = 0; n < 2; ++n) acc[a][b][m][n] = (f32x4){0.f, 0.f, 0.f, 0.f};
    bf16x8 At[4][2], B0[2][2], B1[2][2];
    const char* cA = (const char*)g.A + (size_t)cur.pm * tstep; const char* cB = (const char*)g.Bt + (size_t)cur.pn * tstep;
    PG8_STAGE(PG8_SB(0, 0), cB, voffB); PG8_STAGE(PG8_SB(0, 1), cB + hstep, voffB); PG8_STAGE(PG8_SA(0, 0), cA, voffA); PG8_STAGE(PG8_SA(0, 1), cA + hstep, voffA);
    if (wr == 1) PG8_BAR;
    PG8_WAIT_V(2); PG8_BAR;
    PG8_STAGE(PG8_SB(1, 0), cB + kstep, voffB); PG8_STAGE(PG8_SA(1, 0), cA + kstep, voffA); PG8_STAGE(PG8_SB(1, 1), cB + hstep + kstep, voffB);
    PG8_WAIT_V(6); PG8_BAR;
    for (;;) {
        const bool has_next = S.next(ui + 1, nxt);
        const char* nA = has_next ? (const char*)g.A + (size_t)nxt.pm * tstep : cA; const char* nB = has_next ? (const char*)g.Bt + (size_t)nxt.pn * tstep : cB;
        for (int t = 0; t < nt; t += 2) {
            const bool last = (t == nt - 2);
            const char* a1 = cA + (size_t)(t + 1) * kstep;
            const char* a2 = last ? nA : cA + (size_t)(t + 2) * kstep; const char* b2 = last ? nB : cB + (size_t)(t + 2) * kstep;
            const char* a3 = a2 + kstep; const char* b3 = b2 + kstep;
            PG8_LDB(B0, 0, 0); PG8_LDB(B1, 0, 1); PG8_SCHED; PG8_LDA(At, 0, 0); PG8_STAGE(PG8_SA(1, 1), a1 + hstep, voffA);
            PG8_WAIT_V(8); PG8_WAIT_L(0); PG8_BAR; PG8_MMA(0, 0, At, B0); PG8_MMA(0, 1, At, B1); PG8_BAR; PG8_SCHED;
            PG8_LDA(At, 0, 1); PG8_STAGE(PG8_SB(0, 0), b2, voffB); PG8_STAGE(PG8_SB(0, 1), b2 + hstep, voffB); PG8_STAGE(PG8_SA(0, 0), a2, voffA);
            PG8_WAIT_V(8); PG8_WAIT_L(0); PG8_BAR; PG8_MMA(1, 0, At, B0); PG8_MMA(1, 1, At, B1); PG8_BAR; PG8_SCHED;
            PG8_LDB(B0, 1, 0); PG8_LDB(B1, 1, 1); PG8_SCHED; PG8_LDA(At, 1, 0); PG8_STAGE(PG8_SA(0, 1), a2 + hstep, voffA);
            PG8_WAIT_V(8); PG8_WAIT_L(0); PG8_BAR; PG8_MMA(0, 0, At, B0); PG8_MMA(0, 1, At, B1); PG8_BAR; PG8_SCHED;
            PG8_LDA(At, 1, 1); PG8_STAGE(PG8_SB(1, 0), b3, voffB); PG8_STAGE(PG8_SB(1, 1), b3 + hstep, voffB); PG8_STAGE(PG8_SA(1, 0), a3, voffA);
            PG8_WAIT_V(8); PG8_WAIT_L(0); PG8_BAR; PG8_MMA(1, 0, At, B0); PG8_MMA(1, 1, At, B1); PG8_BAR; PG8_SCHED;
        }
        if (wr == 0) PG8_BAR;
        if constexpr (!Epi::AFTER_DRAIN) E(acc, cur, wr, wc, fr, fq);
        if (!has_next) break;
#pragma unroll
        for (int a = 0; a < 2; ++a)
#pragma unroll
            for (int b = 0; b < 2; ++b)
#pragma unroll
                for (int m = 0; m < 4; ++m)
#pragma unroll
                    for (int n = 0; n < 2; ++n) acc[a][b][m][n] = (f32x4){0.f, 0.f, 0.f, 0.f};
        cur = nxt; cA = nA; cB = nB; ++ui;
        if (wr == 1) PG8_BAR;
    }
    PG8_WAIT_V(0);
    PG8_BAR;
    if constexpr (Epi::AFTER_DRAIN) E.fused(acc, cur, wr, wc, fr, fq, lds, tid, xbar);
#undef PG8_SA
#undef PG8_SB
#undef PG8_STAGE
#undef PG8_LDA
#undef PG8_LDB
#undef PG8_MMA
#undef PG8_WAIT_V
#undef PG8_WAIT_L
#undef PG8_BAR
#undef PG8_SCHED
}
}

template <int MODE> struct Epi {
    static constexpr bool AFTER_DRAIN = false;
    bf16_t* o1; int ld1; int split; bf16_t* o2; int ld2; float* Rm; float* Rt; const float* x; const float* meta; float* side;
    __device__ __forceinline__ float* rptr(int row) const { return row < MMAIN ? Rm + (size_t)row * DM : Rt + (size_t)(row - MMAIN) * DM; }
    __device__ __forceinline__ void store4(int row, int col, f32x4 v) const {
        if (MODE == 0) {
            if (col < split) { u32x2 w = {cvt_pk_bf16(v[0], v[1]), cvt_pk_bf16(v[2], v[3])}; *(u32x2*)(o1 + (size_t)row * ld1 + col) = w; }
            else { u32x2 w = {cvt_pk_bf16(siluf(v[0]), siluf(v[1])), cvt_pk_bf16(siluf(v[2]), siluf(v[3]))}; *(u32x2*)(o2 + (size_t)row * ld2 + (col - split)) = w; }
        } else if (MODE == 1) {
            f32x4 r; for (int i = 0; i < 4; ++i) { const float t = fmaxf(v[i], 0.f); r[i] = t * t; }
            u32x2 w = {cvt_pk_bf16(r[0], r[1]), cvt_pk_bf16(r[2], r[3])}; *(u32x2*)(o1 + (size_t)row * ld1 + col) = w;
        } else if (MODE == 2) {
            const float* hp = row < MMAIN ? x + (size_t)row * DM + col : meta + (size_t)(row - MMAIN) * DM + col;
            const f32x4 h = *(const f32x4*)hp; *(f32x4*)(rptr(row) + col) = h * DN_ALPHA + v;
        } else if (MODE == 3) {
            float* rp = rptr(row) + col; const f32x4 h = *(const f32x4*)rp; *(f32x4*)rp = h * DN_ALPHA + v;
        } else {
            if (col < 32) *(f32x4*)(side + (size_t)row * 32 + col) = v;
        }
    }
    __device__ __forceinline__ void operator()(const f32x4 (&acc)[2][2][4][2], const pg8::Unit& u, int wr, int wc, int fr, int fq) const {
        const int row0 = u.pm * 256 + wr * 64 + fr, colt = u.pn * 256 + wc * 32 + 8 * fq;
        if (MODE == 0 || MODE == 1) {
            const bool sec = (MODE == 0) && (u.pn * 256 >= split);
            bf16_t* base = sec ? o2 + (colt - split) : o1 + colt; const int ld = sec ? ld2 : ld1;
#pragma unroll
            for (int ai = 0; ai < 2; ++ai)
#pragma unroll
                for (int m = 0; m < 4; ++m) {
                    bf16_t* rp = base + (size_t)(row0 + ai * 128 + m * 16) * ld;
#pragma unroll
                    for (int bj = 0; bj < 2; ++bj) {
                        f32x4 v0 = acc[ai][bj][m][0], v1 = acc[ai][bj][m][1];
                        if (MODE == 1) {
#pragma unroll
                            for (int i = 0; i < 4; ++i) { const float a = fmaxf(v0[i], 0.f), b = fmaxf(v1[i], 0.f); v0[i] = a * a; v1[i] = b * b; }
                        } else if (sec) {
#pragma unroll
                            for (int i = 0; i < 4; ++i) { v0[i] = siluf(v0[i]); v1[i] = siluf(v1[i]); }
                        }
                        u32x4 w = {cvt_pk_bf16(v0[0], v0[1]), cvt_pk_bf16(v0[2], v0[3]), cvt_pk_bf16(v1[0], v1[1]), cvt_pk_bf16(v1[2], v1[3])};
                        *(u32x4*)(rp + bj * 128) = w;
                    }
                }
        } else {
#pragma unroll
            for (int ai = 0; ai < 2; ++ai)
#pragma unroll
                for (int m = 0; m < 4; ++m) {
                    const int row = row0 + ai * 128 + m * 16;
                    float* rp = Rm + (size_t)row * DM + colt;
                    const float* hp = (MODE == 2) ? x + (size_t)row * DM + colt : rp;
#pragma unroll
                    for (int bj = 0; bj < 2; ++bj) {
                        const f32x4 h0 = *(const f32x4*)(hp + bj * 128), h1 = *(const f32x4*)(hp + bj * 128 + 4);
                        *(f32x4*)(rp + bj * 128) = h0 * DN_ALPHA + acc[ai][bj][m][0]; *(f32x4*)(rp + bj * 128 + 4) = h1 * DN_ALPHA + acc[ai][bj][m][1];
                    }
                    asm volatile("" ::: "memory");
                    __builtin_amdgcn_sched_barrier(0);
                }
        }
    }
};

template <int RT, class E>
__device__ __forceinline__ void skinny_gemm(LAS uchar* lds, const bf16_t* A, int lda, const bf16_t* Bt, int K, int row0, int nrt, int nct, const E& epi, int task0, int ntask_stride, const int tid) {
    const int wid = tid >> 6, lane = tid & 63, fr = lane & 15, fq = lane >> 4;
    LAS f32x4* red = (LAS f32x4*)lds;
    const int nrg = (nrt + RT - 1) / RT, ntasks = nrg * nct, kw = K / 8;
    for (int task = task0; task < ntasks; task += ntask_stride) {
        const int rg = task / nct, ct = task % nct;
        const bf16_t* bp0 = Bt + (size_t)(32 * ct + fr) * K + wid * kw + 8 * fq;
        const bf16_t* bp1 = bp0 + (size_t)16 * K;
        const bf16_t* ap[RT];
#pragma unroll
        for (int r = 0; r < RT; ++r) { const int rt = (RT * rg + r < nrt) ? RT * rg + r : nrt - 1; ap[r] = A + (size_t)(row0 + 16 * rt + fr) * lda + wid * kw + 8 * fq; }
        f32x4 acc[RT][2];
#pragma unroll
        for (int r = 0; r < RT; ++r) { acc[r][0] = (f32x4){0.f, 0.f, 0.f, 0.f}; acc[r][1] = (f32x4){0.f, 0.f, 0.f, 0.f}; }
#pragma unroll 2
        for (int k = 0; k < kw; k += 32) {
            const bf16x8 b0 = *(const bf16x8*)(bp0 + k), b1 = *(const bf16x8*)(bp1 + k);
#pragma unroll
            for (int r = 0; r < RT; ++r) { const bf16x8 av = *(const bf16x8*)(ap[r] + k); acc[r][0] = MFMA16(b0, av, acc[r][0]); acc[r][1] = MFMA16(b1, av, acc[r][1]); }
        }
#pragma unroll
        for (int r = 0; r < RT; ++r) { red[((wid * RT + r) * 2 + 0) * 64 + lane] = acc[r][0]; red[((wid * RT + r) * 2 + 1) * 64 + lane] = acc[r][1]; }
        __syncthreads();
        for (int o = wid; o < RT * 2; o += 8) {
            const int r = o >> 1, n = o & 1;
            if (RT * rg + r < nrt) {
                f32x4 s = {0.f, 0.f, 0.f, 0.f};
#pragma unroll
                for (int w = 0; w < 8; ++w) s += red[((w * RT + r) * 2 + n) * 64 + lane];
                epi.store4(row0 + 16 * (RT * rg + r) + fr, 32 * ct + 16 * n + 4 * fq, s);
            }
        }
        __syncthreads();
    }
}

__device__ __forceinline__ void transpose_item(const float* W, int ldw, int src0, int nblk, bf16_t* WT, int K, int dst0, LAS float* scr, int item, int lane) {
    const int kb = item / nblk, nb = item % nblk, k0 = 64 * kb, n0 = 32 * nb;
    {
        const int kq = lane >> 3, n4 = (lane & 7) * 4;
        f32x4 v[8];
#pragma unroll
        for (int i = 0; i < 8; ++i) v[i] = *(const f32x4*)(W + (size_t)(k0 + 8 * i + kq) * ldw + src0 + n0 + n4);
#pragma unroll
        for (int i = 0; i < 8; ++i) { LAS float* d = scr + (8 * i + kq) * 33 + n4; d[0] = v[i][0]; d[1] = v[i][1]; d[2] = v[i][2]; d[3] = v[i][3]; }
    }
    asm volatile("s_waitcnt lgkmcnt(0)" ::: "memory");
    const int c = lane & 7;
#pragma unroll
    for (int j = 0; j < 4; ++j) { const int n = (lane >> 3) + 8 * j; const LAS float* s = scr + (8 * c) * 33 + n;
        u32x4 o; o.x = cvt_pk_bf16(s[0 * 33], s[1 * 33]); o.y = cvt_pk_bf16(s[2 * 33], s[3 * 33]); o.z = cvt_pk_bf16(s[4 * 33], s[5 * 33]); o.w = cvt_pk_bf16(s[6 * 33], s[7 * 33]);
        *(u32x4*)(WT + (size_t)(dst0 + n0 + n) * K + k0 + 8 * c) = o; }
    asm volatile("s_waitcnt lgkmcnt(0)" ::: "memory");
}
struct TSeg { const float* W; int ldw, src0, n, K; bf16_t* WT; int dst0; };
template <int NS>
__device__ __forceinline__ void transpose_segs(LAS uchar* lds, const TSeg (&segs)[NS], const int tid) {
    const int lane = tid & 63, wave = tid >> 6;
    LAS float* scr = (LAS float*)(lds + wave * 8704);
    const int gw = blockIdx.x * 8 + wave, NGW = gridDim.x * 8;
    int base = 0, next = gw;
#pragma unroll
    for (int s = 0; s < NS; ++s) {
        const int nblk = segs[s].n / 32, items = nblk * (segs[s].K / 64);
        for (; next < base + items; next += NGW) transpose_item(segs[s].W, segs[s].ldw, segs[s].src0, nblk, segs[s].WT, segs[s].K, segs[s].dst0, scr, next - base, lane);
        base += items;
    }
}

__device__ __forceinline__ float wave_sum(float v) {
#pragma unroll
    for (int o = 1; o < 64; o <<= 1) v += __shfl_xor(v, o);
    return v;
}
__device__ __forceinline__ void ln_phase(float* Rm, float* Rt, const float* w, const float* bia, bf16_t* hb, bool final_, const int tid) {
    const int lane = tid & 63, gw = blockIdx.x * 8 + (tid >> 6), NGW = gridDim.x * 8;
    const int nrows = final_ ? MMAIN : MROWS;
    f32x4 wv[4], bv[4];
#pragma unroll
    for (int j = 0; j < 4; ++j) { wv[j] = ((const f32x4*)w)[lane + 64 * j]; bv[j] = ((const f32x4*)bia)[lane + 64 * j]; }
    for (int row = gw; row < nrows; row += NGW) {
        float* rp = row < MMAIN ? Rm + (size_t)row * DM : Rt + (size_t)(row - MMAIN) * DM;
        f32x4 v[4]; float s = 0.f;
#pragma unroll
        for (int j = 0; j < 4; ++j) { v[j] = ((const f32x4*)rp)[lane + 64 * j]; s += (v[j][0] + v[j][1]) + (v[j][2] + v[j][3]); }
        const float mean = wave_sum(s) * (1.f / DM); float s2 = 0.f;
#pragma unroll
        for (int j = 0; j < 4; ++j) { v[j] = v[j] - mean; s2 += (v[j][0] * v[j][0] + v[j][1] * v[j][1]) + (v[j][2] * v[j][2] + v[j][3] * v[j][3]); }
        const float rstd = 1.f / sqrtf(wave_sum(s2) * (1.f / DM) + 1e-5f);
#pragma unroll
        for (int j = 0; j < 4; ++j) {
            const f32x4 y = v[j] * rstd * wv[j] + bv[j];
            ((f32x4*)rp)[lane + 64 * j] = y;
            if (!final_) { u32x2 o = {cvt_pk_bf16(y[0], y[1]), cvt_pk_bf16(y[2], y[3])}; ((u32x2*)(hb + (size_t)row * DM))[lane + 64 * j] = o; }
        }
    }
}
__device__ __forceinline__ void rmsnorm_phase(bf16_t* Y, const float* nw, const int tid) {
    const int lane = tid & 63, gw = blockIdx.x * 8 + (tid >> 6), NGW = gridDim.x * 8;
    for (int row = gw; row < MROWS; row += NGW) {
        u32x4* yp = (u32x4*)(Y + (size_t)row * 2048 + 32 * lane);
        u32x4 raw[4]; float f[32]; float ss = 0.f;
#pragma unroll
        for (int j = 0; j < 4; ++j) { raw[j] = yp[j];
#pragma unroll
            for (int e = 0; e < 4; ++e) { const unsigned u = raw[j][e]; const float lo = bf2f(u & 0xffffu), hi = bf2f(u >> 16); f[8 * j + 2 * e] = lo; f[8 * j + 2 * e + 1] = hi; ss += lo * lo + hi * hi; } }
        ss = row16_sum(ss);
        const float rstd = 1.f / sqrtf(ss * (1.f / 512.f) + 1e-6f);
        const f32x4* wp = (const f32x4*)(nw + 32 * lane);
#pragma unroll
        for (int j = 0; j < 4; ++j) { const f32x4 w0 = wp[2 * j], w1 = wp[2 * j + 1];
            u32x4 o; o.x = cvt_pk_bf16(f[8 * j] * rstd * w0[0], f[8 * j + 1] * rstd * w0[1]); o.y = cvt_pk_bf16(f[8 * j + 2] * rstd * w0[2], f[8 * j + 3] * rstd * w0[3]);
            o.z = cvt_pk_bf16(f[8 * j + 4] * rstd * w1[0], f[8 * j + 5] * rstd * w1[1]); o.w = cvt_pk_bf16(f[8 * j + 6] * rstd * w1[2], f[8 * j + 7] * rstd * w1[3]);
            yp[j] = o; }
    }
}

__device__ __forceinline__ void conv8(const bf16_t* P, int ld, int b, int L, int col0, const float* cw, int cwld, int wcol0, const float* cb, float (&out)[8]) {
#pragma unroll
    for (int e = 0; e < 8; ++e) out[e] = cb ? cb[wcol0 + e] : 0.f;
#pragma unroll
    for (int j = 0; j < 4; ++j) {
        const int Lj = L - 3 + j;
        if (Lj >= 48) {
            const u32x4 raw = *(const u32x4*)(P + (size_t)tok_row(b, Lj) * ld + col0);
            const f32x4 w0 = *(const f32x4*)(cw + (size_t)j * cwld + wcol0), w1 = *(const f32x4*)(cw + (size_t)j * cwld + wcol0 + 4);
            out[0] += bf2f(raw[0] & 0xffffu) * w0[0]; out[1] += bf2f(raw[0] >> 16) * w0[1]; out[2] += bf2f(raw[1] & 0xffffu) * w0[2]; out[3] += bf2f(raw[1] >> 16) * w0[3];
            out[4] += bf2f(raw[2] & 0xffffu) * w1[0]; out[5] += bf2f(raw[2] >> 16) * w1[1]; out[6] += bf2f(raw[3] & 0xffffu) * w1[2]; out[7] += bf2f(raw[3] >> 16) * w1[3];
        }
    }
#pragma unroll
    for (int e = 0; e < 8; ++e) out[e] = siluf(out[e]);
}
__device__ __forceinline__ u32x4 pk8(const float (&v)[8]) { u32x4 o = {cvt_pk_bf16(v[0], v[1]), cvt_pk_bf16(v[2], v[3]), cvt_pk_bf16(v[4], v[5]), cvt_pk_bf16(v[6], v[7])}; return o; }

__device__ __forceinline__ int range_row0(int rr) { return rr < 512 ? (rr >> 8) * SEQ + 32 * (rr & 255) : MMAIN; }
__device__ __forceinline__ void halo_save(const bf16_t* P, int ld, int col0, int ncg, bf16_t* HS, const int tid) {
    const int total = 513 * 3 * ncg;
    for (int it = blockIdx.x * NTHREADS + tid; it < total; it += gridDim.x * NTHREADS) {
        const int cgp = it % ncg, k = (it / ncg) % 3, rr = it / (3 * ncg);
        u32x4 v = {0u, 0u, 0u, 0u};
        if (rr < 512) { const int row = ((rr & 255) == 0) ? (MMAIN + 13 + k) : (range_row0(rr) - 3 + k); v = *(const u32x4*)(P + (size_t)row * ld + col0 + 8 * cgp); }
        *(u32x4*)(HS + ((size_t)(rr * 3 + k) * ncg + cgp) * 8) = v;
    }
}
__device__ __forceinline__ void unpack8(const u32x4 raw, float (&o)[8]) {
#pragma unroll
    for (int e = 0; e < 4; ++e) { o[2 * e] = bf2f(raw[e] & 0xffffu); o[2 * e + 1] = bf2f(raw[e] >> 16); }
}
template <int KIND>
__device__ __forceinline__ void conv_inplace(bf16_t* P, int ld, int col0, int ncg, const bf16_t* HS, const Params& p, const int tid) {
    const int total = 513 * ncg;
    for (int it = blockIdx.x * NTHREADS + tid; it < total; it += gridDim.x * NTHREADS) {
        const int cgp = it % ncg, rr = it / ncg;
        const float* cw; int cwld, wc; const float* cb = nullptr; bool norm = false; float scale = 1.f;
        if (KIND == 0) {
            if (cgp < 64) { cw = p.in[I_CONVQ]; cwld = 512; wc = 8 * cgp; norm = true; scale = 0.08838834764831845f; }
            else if (cgp < 128) { cw = p.in[I_CONVK]; cwld = 512; wc = 8 * (cgp - 64); norm = true; }
            else { cw = p.in[I_CONVV]; cwld = 1024; wc = 8 * (cgp - 128); }
        } else { cw = p.in[I_CCONVW]; cwld = 3072; wc = 8 * cgp; cb = p.in[I_CCONVB]; }
        float c0[8], c1[8], c2[8], c3[8], bs[8];
#pragma unroll
        for (int e = 0; e < 8; ++e) { c0[e] = cw[wc + e]; c1[e] = cw[cwld + wc + e]; c2[e] = cw[2 * cwld + wc + e]; c3[e] = cw[3 * cwld + wc + e]; bs[e] = cb ? cb[wc + e] : 0.f; }
        float w0[8], w1[8], w2[8];
        unpack8(*(const u32x4*)(HS + ((size_t)(rr * 3 + 0) * ncg + cgp) * 8), w0);
        unpack8(*(const u32x4*)(HS + ((size_t)(rr * 3 + 1) * ncg + cgp) * 8), w1);
        unpack8(*(const u32x4*)(HS + ((size_t)(rr * 3 + 2) * ncg + cgp) * 8), w2);
        bf16_t* rp = P + (size_t)range_row0(rr) * ld + col0 + 8 * cgp;
        const int len = rr < 512 ? 32 : 16;
#pragma unroll 8
        for (int r = 0; r < len; ++r) {
            float cur[8], o[8];
            unpack8(*(const u32x4*)(rp + (size_t)r * ld), cur);
            float ss = 0.f;
#pragma unroll
            for (int e = 0; e < 8; ++e) { const float a = bs[e] + w0[e] * c0[e] + w1[e] * c1[e] + w2[e] * c2[e] + cur[e] * c3[e]; o[e] = siluf(a); ss += o[e] * o[e]; w0[e] = w1[e]; w1[e] = w2[e]; w2[e] = cur[e]; }
            if (KIND == 0) {
                ss = row16_sum(ss);
                const float sc = norm ? scale / sqrtf(ss + 1e-6f) : 1.f;
#pragma unroll
                for (int e = 0; e < 8; ++e) o[e] *= sc;
            }
            u32x4 ov = {cvt_pk_bf16(o[0], o[1]), cvt_pk_bf16(o[2], o[3]), cvt_pk_bf16(o[4], o[5]), cvt_pk_bf16(o[6], o[7])};
            *(u32x4*)(rp + (size_t)r * ld) = ov;
        }
    }
}
__device__ __forceinline__ void rope_inplace(bf16_t* P, const uchar* ws, const int tid) {
    const int lane = tid & 63, gw = blockIdx.x * 8 + (tid >> 6), NGW = gridDim.x * 8;
    const int isk = lane >> 5, cgp = lane & 7, col = (lane >> 3) * 128 + 8 * cgp;
    const float sc = isk ? 1.f : 0.08838834764831845f;
    for (int row0 = gw; row0 < MROWS; row0 += 2 * NGW) {
        u32x4 r1[2], r2[2]; f32x2 csv[2][8]; bool ok[2];
#pragma unroll
        for (int q = 0; q < 2; ++q) {
            const int row = row0 + q * NGW; ok[q] = row < MROWS;
            if (ok[q]) {
                const int L = row < MMAIN ? 64 + (row & (SEQ - 1)) : 48 + (row - MMAIN);
                const bf16_t* rp = P + (size_t)row * 4096 + col;
                r1[q] = *(const u32x4*)rp; r2[q] = *(const u32x4*)(rp + 64);
                const f32x2* cs = (const f32x2*)(ws + OFF_CS) + (size_t)L * 64 + 8 * cgp;
#pragma unroll
                for (int e = 0; e < 8; ++e) csv[q][e] = cs[e];
            }
        }
#pragma unroll
        for (int q = 0; q < 2; ++q) {
            if (ok[q]) {
                bf16_t* rp = P + (size_t)(row0 + q * NGW) * 4096 + col;
                float x1[8], x2[8], o1[8], o2[8];
                unpack8(r1[q], x1); unpack8(r2[q], x2);
#pragma unroll
                for (int e = 0; e < 8; ++e) { const f32x2 c = csv[q][e]; o1[e] = (x1[e] * c[0] - x2[e] * c[1]) * sc; o2[e] = (x1[e] * c[1] + x2[e] * c[0]) * sc; }
                u32x4 a = {cvt_pk_bf16(o1[0], o1[1]), cvt_pk_bf16(o1[2], o1[3]), cvt_pk_bf16(o1[4], o1[5]), cvt_pk_bf16(o1[6], o1[7])};
                u32x4 bq = {cvt_pk_bf16(o2[0], o2[1]), cvt_pk_bf16(o2[2], o2[3]), cvt_pk_bf16(o2[4], o2[5]), cvt_pk_bf16(o2[6], o2[7])};
                *(u32x4*)rp = a; *(u32x4*)(rp + 64) = bq;
            }
        }
    }
}

constexpr int L_Q = 0, L_K = 17408, L_KT = 34816, L_V = 53248, L_ATT = 87040, L_TINV = 104448, L_FL = 113664;
constexpr int QS = 136  , KTS = 72, VS = 264, ATS = 68, TIS = 72;
constexpr int F_GC = 0, F_EG = 256, F_DL = 512, F_DT = 768, F_BETA = 1024, F_EL = 1088, F_PQ = 1152, F_PK = 2176, F_RED = 3200, F_RST = 4224;

template <int NC>
__device__ __forceinline__ void copy_tile(LAS uchar* lds, int ldsoff, int STR, const bf16_t* P, int ld, int col0, int b, int c, const int tid) {
    constexpr int NCG = NC / 8, RPI = 512 / NCG, NIT = 64 / RPI;
#pragma unroll
    for (int i = 0; i < NIT; ++i) {
        const int t = tid / NCG + RPI * i, cgp = tid % NCG, L = 64 * c + t;
        u32x4 raw = {0u, 0u, 0u, 0u};
        if (L >= 48) raw = *(const u32x4*)(P + (size_t)tok_row(b, L) * ld + col0 + 8 * cgp);
        *(LAS u32x4*)(lds + ldsoff + (t * STR + 8 * cgp) * 2) = raw;
    }
}
template <int NC>
__device__ __forceinline__ void tile_load(u32x4 (&r)[512 / (NC / 8) == 32 ? 2 : 4], const bf16_t* P, int ld, int col0, int b, int c, const int tid) {
    constexpr int NCG = NC / 8, RPI = 512 / NCG, NIT = 64 / RPI;
#pragma unroll
    for (int i = 0; i < NIT; ++i) {
        const int t = tid / NCG + RPI * i, cgp = tid % NCG, L = 64 * c + t;
        r[i] = (u32x4){0u, 0u, 0u, 0u};
        if (L >= 48) r[i] = *(const u32x4*)(P + (size_t)tok_row(b, L) * ld + col0 + 8 * cgp);
    }
}
template <int NC>
__device__ __forceinline__ void tile_store(LAS uchar* lds, int ldsoff, int STR, const u32x4 (&r)[512 / (NC / 8) == 32 ? 2 : 4], const int tid) {
    constexpr int NCG = NC / 8, RPI = 512 / NCG, NIT = 64 / RPI;
#pragma unroll
    for (int i = 0; i < NIT; ++i) { const int t = tid / NCG + RPI * i, cgp = tid % NCG; *(LAS u32x4*)(lds + ldsoff + (t * STR + 8 * cgp) * 2) = r[i]; }
}
__device__ __forceinline__ void make_kT(LAS uchar* lds, const int tid) {
#pragma unroll
    for (int i = 0; i < 2; ++i) {
        const int item = tid + 512 * i, t = item & 63, cgp = item >> 6;
        const u32x4 v = *(const LAS u32x4*)(lds + L_K + (t * QS + 8 * cgp) * 2);
#pragma unroll
        for (int e = 0; e < 4; ++e) {
            *(LAS bf16_t*)(lds + L_KT + ((8 * cgp + 2 * e) * KTS + t) * 2) = (bf16_t)(v[e] & 0xffffu);
            *(LAS bf16_t*)(lds + L_KT + ((8 * cgp + 2 * e + 1) * KTS + t) * 2) = (bf16_t)(v[e] >> 16);
        }
    }
}
__device__ __forceinline__ void gdn_load_gates(LAS uchar* lds, const Params& p, uchar* ws, int b, int h, int c, const int tid) {
    LAS float* FL = (LAS float*)(lds + L_FL);
    if (tid < 64) {
        const int t = tid, L = 64 * c + t; float beta = 0.f, g = 0.f;
        if (L >= 48) {
            const float* sp = (const float*)(ws + OFF_SIDE) + (size_t)tok_row(b, L) * 32;
            beta = 1.f / (1.f + __expf(-sp[h]));
            g = -__expf(p.in[I_ABALOG][h]) * softplusf(sp[4 + h] + p.in[I_ABDTB][h]);
        }
        float v = g;
#pragma unroll
        for (int o = 1; o < 64; o <<= 1) { const float n = __shfl_up(v, o); if (t >= o) v += n; }
        const float gl = __shfl(v, 63);
        FL[F_BETA + t] = beta; FL[F_GC + t] = v; FL[F_EG + t] = __expf(v); FL[F_DL + t] = __expf(gl - v);
        if (t == 63) FL[F_EL] = __expf(gl);
    }
}

__device__ __forceinline__ void tinv_phase(LAS uchar* lds, const Params& p, uchar* ws, const int tid) {
    const int wid = tid >> 6, lane = tid & 63, fr = lane & 15, fq = lane >> 4;
    const bf16_t* P = (const bf16_t*)(ws + OFF_P);
    LAS float* FL = (LAS float*)(lds + L_FL);
    LAS float* AL = (LAS float*)(lds + L_ATT);
    for (int task = blockIdx.x; task < 2 * NCHUNK * 4; task += gridDim.x) {
        const int h = task & 3, c = (task >> 2) % NCHUNK, b = (task >> 2) / NCHUNK;
        __syncthreads();
        gdn_load_gates(lds, p, ws, b, h, c, tid);
        copy_tile<128>(lds, L_K, QS, P, 4096, 2560 + h * 128, b, c, tid);
        __syncthreads();
        {
            const int tt = wid >> 1, st0 = (wid & 1) * 2;
            f32x4 at[2] = {{0.f, 0.f, 0.f, 0.f}, {0.f, 0.f, 0.f, 0.f}};
#pragma unroll
            for (int ks = 0; ks < 4; ++ks) {
                const bf16x8 a = *(const LAS bf16x8*)(lds + L_K + ((16 * tt + fr) * QS + 32 * ks + 8 * fq) * 2);
#pragma unroll
                for (int u = 0; u < 2; ++u) { const bf16x8 bb = *(const LAS bf16x8*)(lds + L_K + ((16 * (st0 + u) + fr) * QS + 32 * ks + 8 * fq) * 2); at[u] = MFMA16(a, bb, at[u]); }
            }
#pragma unroll
            for (int u = 0; u < 2; ++u)
#pragma unroll
                for (int j = 0; j < 4; ++j) {
                    const int t = 16 * tt + 4 * fq + j, s = 16 * (st0 + u) + fr;
                    const float v = (s < t) ? FL[F_BETA + t] * at[u][j] * __expf(FL[F_GC + t] - FL[F_GC + s]) : 0.f;
                    AL[t * ATS + s] = v;
                }
        }
        __syncthreads();
        if (wid == 0) {
            int alb0 = L_ATT; asm volatile("" : "+v"(alb0));
            float x[64];
#pragma unroll
            for (int t = 0; t < 64; ++t) x[t] = 0.f;
#pragma unroll
            for (int t = 0; t < 64; ++t) {
                float a0 = (t == lane) ? 1.f : 0.f, a1 = 0.f, a2 = 0.f, a3 = 0.f;
#pragma unroll
                for (int s4 = 0; s4 * 4 < t; ++s4) {
                    const f32x4 a = *(const LAS f32x4*)(lds + alb0 + (t * ATS + 4 * s4) * 4);
                    a0 -= a[0] * x[4 * s4]; a1 -= a[1] * x[4 * s4 + 1]; a2 -= a[2] * x[4 * s4 + 2]; a3 -= a[3] * x[4 * s4 + 3];
                }
                x[t] = (a0 + a1) + (a2 + a3);
            }
            bf16_t* tp = (bf16_t*)(ws + OFF_TINV) + (size_t)task * 4096;
#pragma unroll
            for (int t = 0; t < 64; ++t) tp[t * 64 + lane] = (bf16_t)f2bf(x[t]);
        }
    }
}

#define LB(name, expr) int name = (expr); asm volatile("" : "+v"(name))
template <int MODE, int PASS, int NT, bool PF_Q = true, bool PF_K = true, bool PF_V = true>
__device__ __forceinline__ void scan_unit(LAS uchar* lds, const Params& p, uchar* ws, int b, int hd, int c0, int c1, const float* Sin, float* Sout, float* Gout, const int tid, const int cfull = 0) {
    constexpr bool GDN = (MODE == 1 || MODE == 3);
    constexpr int NCOL = 128 * NT;
    const int wid = __builtin_amdgcn_readfirstlane(tid >> 6), lane = tid & 63, fr = lane & 15, fq = lane >> 4;
    const bf16_t* P = (const bf16_t*)(ws + OFF_P);
    bf16_t* Y = (bf16_t*)(ws + OFF_Y);
    LAS float* FL = (LAS float*)(lds + L_FL);
    constexpr int LDP = (MODE == 2) ? 3072 : 4096;
    const int qc = MODE == 0 ? hd * 128 : (GDN ? 2048 + hd * 128 : 2560 + (hd >> 1) * 128);
    const int kc = MODE == 0 ? 512 + hd * 128 : (GDN ? 2560 + hd * 128 : 2048 + (hd >> 1) * 128);
    const int vc = MODE == 0 ? 1024 + hd * 256 : (GDN ? 3072 + hd * 256 : hd * 256);
    const int yc = GDN ? 1024 + hd * 256 : hd * 256;
    const int hl = (MODE == 2) ? (wid >> 1) : 0;
    const int dvw = 16 * NT * wid;
    const float lg = (MODE == 0) ? log1pf(-exp2f(-5.f - (float)hd)) : 0.f;
    float Gacc = 0.f;
    f32x4 S[8][NT];
#pragma unroll
    for (int m = 0; m < 8; ++m)
#pragma unroll
        for (int n = 0; n < NT; ++n) {
            if (MODE == 3) {
#pragma unroll
                for (int j = 0; j < 4; ++j) S[m][n][j] = (16 * m + 4 * fq + j == dvw + 16 * n + fr) ? 1.f : 0.f;
            } else if (Sin) {
#pragma unroll
                for (int j = 0; j < 4; ++j) S[m][n][j] = Sin[(size_t)(16 * m + 4 * fq + j) * NCOL + dvw + 16 * n + fr];
            } else S[m][n] = (f32x4){0.f, 0.f, 0.f, 0.f};
        }

    constexpr bool PFQ = (PASS == 0) && PF_Q, PFK = PF_K, PFV = (MODE != 3) && PF_V;
    u32x4 pq[2], pk[2], pv[4];
    {
        int tl0 = tid; asm volatile("" : "+v"(tl0));
        if (PFQ) tile_load<128>(pq, P, LDP, qc, b, c0, tl0);
        if (PFK) tile_load<128>(pk, P, LDP, kc, b, c0, tl0);
        if (PFV && PASS == 1) tile_load<256>(pv, P, LDP, vc, b, c0, tl0);
    }
    for (int c = c0; c < c1; ++c) {
        __syncthreads();
        int tl = tid; asm volatile("" : "+v"(tl));
        if (PASS == 0) { if (PFQ) tile_store<128>(lds, L_Q, QS, pq, tl); else copy_tile<128>(lds, L_Q, QS, P, LDP, qc, b, c, tl); }
        if (PFK) tile_store<128>(lds, L_K, QS, pk, tl); else copy_tile<128>(lds, L_K, QS, P, LDP, kc, b, c, tl);
        if (MODE != 3) {
            if (PASS == 0 && PFV) { if (c == c0) copy_tile<256>(lds, L_V, VS, P, LDP, vc, b, c, tl); }
            else if (PFV) tile_store<256>(lds, L_V, VS, pv, tl); else copy_tile<256>(lds, L_V, VS, P, LDP, vc, b, c, tl);
        }
        if (PASS == 1 && c + 1 < c1) {
            if (PFQ) tile_load<128>(pq, P, LDP, qc, b, c + 1, tl);
            if (PFK) tile_load<128>(pk, P, LDP, kc, b, c + 1, tl);
            if (PFV) tile_load<256>(pv, P, LDP, vc, b, c + 1, tl);
        }
        if (MODE == 0) {
            if (tl < 64) { const float v = lg * (float)(tl + 1); FL[F_GC + tl] = v; FL[F_EG + tl] = __expf(v); FL[F_DL + tl] = __expf(lg * 64.f - v); if (tl == 63) FL[F_EL] = __expf(lg * 64.f); }
        } else if (GDN) {
            gdn_load_gates(lds, p, ws, b, hd, c, tl);
            {
                const int t = tl >> 3, sg = tl & 7;
                const bf16_t* tp = (const bf16_t*)(ws + OFF_TINV) + (size_t)(((b * NCHUNK + c) << 2) + hd) * 4096;
                *(LAS u32x4*)(lds + L_TINV + (t * TIS + 8 * sg) * 2) = *(const u32x4*)(tp + t * 64 + 8 * sg);
            }
        } else {
            if (tl < 256) {
                const int t = tl & 63, hq = tl >> 6, head = hd * 4 + hq, L = 64 * c + t; float dt = 0.f, g = 0.f;
                if (L >= 48) {
                    const float* sp = (const float*)(ws + OFF_SIDE) + (size_t)tok_row(b, L) * 32;
                    dt = softplusf(sp[head] + p.in[I_CDTB][head]); g = -__expf(p.in[I_CALOG][head]) * dt;
                }
                float v = g;
#pragma unroll
                for (int o = 1; o < 64; o <<= 1) { const float n = __shfl_up(v, o); if (t >= o) v += n; }
                const float gl = __shfl(v, 63);
                FL[F_DT + hq * 64 + t] = dt; FL[F_GC + hq * 64 + t] = v; FL[F_EG + hq * 64 + t] = __expf(v); FL[F_DL + hq * 64 + t] = __expf(gl - v);
                if (t == 63) { FL[F_EL + hq] = __expf(gl); FL[F_EL + 4 + hq] = gl; }
            }
        }
        __syncthreads();
        make_kT(lds, tl);
        const bool full = (PASS == 0) && (c >= cfull);
        if (!full) __syncthreads();
        if (MODE == 2 && PASS == 1) Gacc += FL[F_EL + 4 + hl];
        if (PASS == 0 && full) {
            LB(qnb, L_Q + ((16 * (wid >> 1) + fr) * QS + 8 * fq) * 2); LB(knb, L_K + ((32 * (wid & 1) + fr) * QS + 8 * fq) * 2);
            LB(awb, L_ATT + ((16 * (wid >> 1) + 4 * fq) * ATS + 32 * (wid & 1) + fr) * 4);
            f32x4 at[2] = {{0.f, 0.f, 0.f, 0.f}, {0.f, 0.f, 0.f, 0.f}};
#pragma unroll
            for (int ks = 0; ks < 4; ++ks) {
                const bf16x8 a = *(const LAS bf16x8*)(lds + qnb + 64 * ks);
#pragma unroll
                for (int u = 0; u < 2; ++u) { const bf16x8 bb = *(const LAS bf16x8*)(lds + knb + u * (16 * QS * 2) + 64 * ks); at[u] = MFMA16(a, bb, at[u]); }
            }
#pragma unroll
            for (int u = 0; u < 2; ++u)
#pragma unroll
                for (int j = 0; j < 4; ++j) *(LAS float*)(lds + awb + (j * ATS + 16 * u) * 4) = at[u][j];
        }
        __builtin_amdgcn_sched_barrier(0);
        f32x4 Vn[4][NT];
        if (GDN) {
            LB(kpb, L_K + (fr * QS + 4 * fq) * 2); LB(flq, L_FL + (hl * 64 + 4 * fq) * 4); LB(vb, L_V + ((4 * fq) * VS + dvw + fr) * 2); LB(tib, L_TINV + (fr * TIS + 4 * fq) * 2);
            f32x4 R_[4][NT];
#pragma unroll
            for (int st = 0; st < 4; ++st)
#pragma unroll
                for (int n = 0; n < NT; ++n) R_[st][n] = (f32x4){0.f, 0.f, 0.f, 0.f};
#pragma unroll
            for (int ks = 0; ks < 4; ++ks) {
                bf16x8 bfr[NT];
#pragma unroll
                for (int n = 0; n < NT; ++n) bfr[n] = pack8(S[2 * ks][n], S[2 * ks + 1][n]);
#pragma unroll
                for (int st = 0; st < 4; ++st) {
                    const LAS uchar* ap = lds + kpb + (16 * st * QS + 32 * ks) * 2;
                    const bf16x8 a = mk8(*(const LAS u32x2*)ap, *(const LAS u32x2*)(ap + 32));
#pragma unroll
                    for (int n = 0; n < NT; ++n) R_[st][n] = MFMA16(a, bfr[n], R_[st][n]);
                }
            }
#pragma unroll
            for (int st = 0; st < 4; ++st) {
                const f32x4 be = *(const LAS f32x4*)(lds + flq + (F_BETA + 16 * st) * 4), eg = *(const LAS f32x4*)(lds + flq + (F_EG + 16 * st) * 4);
#pragma unroll
                for (int n = 0; n < NT; ++n)
#pragma unroll
                    for (int j = 0; j < 4; ++j) {
                        float v = 0.f;
                        if (MODE == 1) v = bf2f(*(const LAS bf16_t*)(lds + vb + ((16 * st + j) * VS + 16 * n) * 2));
                        R_[st][n][j] = be[j] * (v - eg[j] * R_[st][n][j]);
                    }
            }
#pragma unroll
            for (int tt = 0; tt < 4; ++tt)
#pragma unroll
                for (int n = 0; n < NT; ++n) Vn[tt][n] = (f32x4){0.f, 0.f, 0.f, 0.f};
#pragma unroll
            for (int ks = 0; ks < 2; ++ks) {
                bf16x8 bfr[NT];
#pragma unroll
                for (int n = 0; n < NT; ++n) bfr[n] = pack8(R_[2 * ks][n], R_[2 * ks + 1][n]);
#pragma unroll
                for (int tt = 0; tt < 4; ++tt) {
                    const LAS uchar* ap = lds + tib + (16 * tt * TIS + 32 * ks) * 2;
                    const bf16x8 a = mk8(*(const LAS u32x2*)ap, *(const LAS u32x2*)(ap + 32));
#pragma unroll
                    for (int n = 0; n < NT; ++n) Vn[tt][n] = MFMA16(a, bfr[n], Vn[tt][n]);
                }
            }
        } else {
            LB(flq, L_FL + (hl * 64 + 4 * fq) * 4); LB(vb, L_V + ((4 * fq) * VS + dvw + fr) * 2);
#pragma unroll
            for (int st = 0; st < 4; ++st) {
                f32x4 dtv = {1.f, 1.f, 1.f, 1.f};
                if (MODE == 2) dtv = *(const LAS f32x4*)(lds + flq + (F_DT + 16 * st) * 4);
#pragma unroll
                for (int n = 0; n < NT; ++n)
#pragma unroll
                    for (int j = 0; j < 4; ++j)
                        Vn[st][n][j] = bf2f(*(const LAS bf16_t*)(lds + vb + ((16 * st + j) * VS + 16 * n) * 2)) * dtv[j];
            }
        }
        __builtin_amdgcn_sched_barrier(0);
        f32x4 O[4][NT];
        if (PASS == 0 && full) {
            {
                LB(qpb, L_Q + (fr * QS + 4 * fq) * 2); LB(flq, L_FL + (hl * 64 + 4 * fq) * 4);
#pragma unroll
                for (int tt = 0; tt < 4; ++tt)
#pragma unroll
                    for (int n = 0; n < NT; ++n) O[tt][n] = (f32x4){0.f, 0.f, 0.f, 0.f};
#pragma unroll
                for (int ks = 0; ks < 4; ++ks) {
                    bf16x8 bfr[NT];
#pragma unroll
                    for (int n = 0; n < NT; ++n) bfr[n] = pack8(S[2 * ks][n], S[2 * ks + 1][n]);
#pragma unroll
                    for (int tt = 0; tt < 4; ++tt) {
                        const LAS uchar* ap = lds + qpb + (16 * tt * QS + 32 * ks) * 2;
                        const bf16x8 a = mk8(*(const LAS u32x2*)ap, *(const LAS u32x2*)(ap + 32));
#pragma unroll
                        for (int n = 0; n < NT; ++n) O[tt][n] = MFMA16(a, bfr[n], O[tt][n]);
                    }
                }
#pragma unroll
                for (int tt = 0; tt < 4; ++tt) {
                    const f32x4 eg = *(const LAS f32x4*)(lds + flq + (F_EG + 16 * tt) * 4);
#pragma unroll
                    for (int n = 0; n < NT; ++n) O[tt][n] = O[tt][n] * eg;
                }
            }
            __syncthreads();
            u32x4 gate[4];
            const bool wr_ok = !(c == 0 && b == 1);
            const int rowbase = (c == 0) ? (MMAIN - 48) : (b * SEQ + (c - 1) * 64);
#pragma unroll
            for (int i = 0; i < 4; ++i) {
                const int t = (tid >> 5) + 16 * i;
                gate[i] = (u32x4){0u, 0u, 0u, 0u};
                if (wr_ok && (c > 0 || t >= 48)) gate[i] = *(const u32x4*)(Y + (size_t)(rowbase + t) * 2048 + yc + 8 * (tid & 31));
            }
            if (PFV && c + 1 < c1) { int tl3 = tid; asm volatile("" : "+v"(tl3)); tile_load<256>(pv, P, LDP, vc, b, c + 1, tl3); }
            {
                LB(alb, L_ATT + (fr * ATS + 4 * fq) * 4); LB(flq, L_FL + (hl * 64 + 4 * fq) * 4); LB(flr, L_FL + (hl * 64 + fr) * 4);
#pragma unroll
                for (int ks = 0; ks < 2; ++ks) {
                    bf16x8 bfr[NT];
#pragma unroll
                    for (int n = 0; n < NT; ++n) bfr[n] = pack8(Vn[2 * ks][n], Vn[2 * ks + 1][n]);
                    const int s_lo = 32 * ks + 4 * fq, s_hi = s_lo + 16;
                    const f32x4 gs_lo = *(const LAS f32x4*)(lds + flq + (F_GC + 32 * ks) * 4), gs_hi = *(const LAS f32x4*)(lds + flq + (F_GC + 32 * ks + 16) * 4);
#pragma unroll
                    for (int tt = 0; tt < 4; ++tt) {
                        const int t = 16 * tt + fr; const float gt = *(const LAS float*)(lds + flr + (F_GC + 16 * tt) * 4);
                        f32x4 a_lo = *(const LAS f32x4*)(lds + alb + (16 * tt * ATS + 32 * ks) * 4), a_hi = *(const LAS f32x4*)(lds + alb + (16 * tt * ATS + 32 * ks + 16) * 4);
#pragma unroll
                        for (int j = 0; j < 4; ++j) {
                            a_lo[j] = (s_lo + j <= t) ? a_lo[j] * __expf(gt - gs_lo[j]) : 0.f;
                            a_hi[j] = (s_hi + j <= t) ? a_hi[j] * __expf(gt - gs_hi[j]) : 0.f;
                        }
                        const bf16x8 a = pack8(a_lo, a_hi);
#pragma unroll
                        for (int n = 0; n < NT; ++n) O[tt][n] = MFMA16(a, bfr[n], O[tt][n]);
                    }
                }
            }
#pragma unroll
            for (int i = 0; i < 4; ++i) *(LAS u32x4*)(lds + (((tid >> 5) + 16 * i) * VS + 8 * (tid & 31)) * 2) = gate[i];
        }
        __builtin_amdgcn_sched_barrier(0);
        {
            LB(ktb, L_KT + (fr * KTS + 4 * fq) * 2); LB(flq, L_FL + (hl * 64 + 4 * fq) * 4);
            const float el = FL[F_EL + hl];
#pragma unroll
            for (int m = 0; m < 8; ++m)
#pragma unroll
                for (int n = 0; n < NT; ++n) S[m][n] = S[m][n] * el;
#pragma unroll
            for (int ks = 0; ks < 2; ++ks) {
                const f32x4 d0 = *(const LAS f32x4*)(lds + flq + (F_DL + 32 * ks) * 4), d1 = *(const LAS f32x4*)(lds + flq + (F_DL + 32 * ks + 16) * 4);
                bf16x8 bfr[NT];
#pragma unroll
                for (int n = 0; n < NT; ++n) bfr[n] = pack8(Vn[2 * ks][n] * d0, Vn[2 * ks + 1][n] * d1);
#pragma unroll
                for (int m = 0; m < 8; ++m) {
                    const LAS uchar* ap = lds + ktb + (16 * m * KTS + 32 * ks) * 2;
                    const bf16x8 a = mk8(*(const LAS u32x2*)ap, *(const LAS u32x2*)(ap + 32));
#pragma unroll
                    for (int n = 0; n < NT; ++n) S[m][n] = MFMA16(a, bfr[n], S[m][n]);
                }
            }
        }
        __builtin_amdgcn_sched_barrier(0);
        if (PASS == 0 && c + 1 < c1) {
            int tl2 = tid; asm volatile("" : "+v"(tl2));
            if (PFQ) tile_load<128>(pq, P, LDP, qc, b, c + 1, tl2);
            if (PFK) tile_load<128>(pk, P, LDP, kc, b, c + 1, tl2);
        }
        if (PASS == 0 && full) {
            LB(rdb, L_FL + (F_RED + (4 * fq * 8 + wid) * 2) * 4); LB(rsb, L_FL + (F_RST + 4 * fq * 2) * 4); LB(vb2, L_V + ((4 * fq) * VS + dvw + fr) * 2);
            LB(stb, ((4 * fq) * VS + dvw + fr) * 2);
            if (MODE != 2) {
#pragma unroll
                for (int tt = 0; tt < 4; ++tt)
#pragma unroll
                    for (int j = 0; j < 4; ++j) {
                        float s1 = 0.f, s2 = 0.f;
#pragma unroll
                        for (int n = 0; n < NT; ++n) { s1 += O[tt][n][j]; s2 += O[tt][n][j] * O[tt][n][j]; }
                        s1 = row16_sum(s1); s2 = row16_sum(s2);
                        if (fr == 0) *(LAS f32x2*)(lds + rdb + ((16 * tt + j) * 8) * 8) = (f32x2){s1, s2};
                    }
                __syncthreads();
                if (tid < 64) {
                    float s1 = 0.f, s2 = 0.f;
#pragma unroll
                    for (int w = 0; w < 8; ++w) { s1 += FL[F_RED + (tid * 8 + w) * 2]; s2 += FL[F_RED + (tid * 8 + w) * 2 + 1]; }
                    float mean, rstd;
                    if (MODE == 0) { mean = s1 * (1.f / 256.f); const float var = fmaxf(s2 * (1.f / 256.f) - mean * mean, 0.f); rstd = 1.f / sqrtf(var + 1e-5f); }
                    else { mean = 0.f; rstd = 1.f / sqrtf(s2 * (1.f / 256.f) + 1e-6f); }
                    FL[F_RST + 2 * tid] = mean; FL[F_RST + 2 * tid + 1] = rstd;
                }
            }
            if (MODE == 2) {
                const float dsk = p.in[I_CD][hd * 4 + hl];
#pragma unroll
                for (int n = 0; n < NT; ++n)
#pragma unroll
                    for (int tt = 0; tt < 4; ++tt)
#pragma unroll
                        for (int j = 0; j < 4; ++j) O[tt][n][j] += bf2f(*(const LAS bf16_t*)(lds + vb2 + ((16 * tt + j) * VS + 16 * n) * 2)) * dsk;
            }
            __syncthreads();
            if (PFV && c + 1 < c1) { int tl4 = tid; asm volatile("" : "+v"(tl4)); tile_store<256>(lds, L_V, VS, pv, tl4); }
            {
                const float* nw = (MODE == 0) ? p.in[I_RETGN] + hd * 256 : p.in[I_GDNNW];
#pragma unroll
                for (int n = 0; n < NT; ++n) {
                    float wgt = 1.f;
                    if (MODE == 0 || MODE == 1) wgt = nw[dvw + 16 * n + fr];
                    if (MODE == 2) wgt = p.in[I_CD][hd * 4 + hl];
#pragma unroll
                    for (int tt = 0; tt < 4; ++tt) {
#pragma unroll
                        for (int j = 0; j < 4; ++j) {
                            float val;
                            if (MODE == 2) val = O[tt][n][j];
                            else { const f32x2 ms = *(const LAS f32x2*)(lds + rsb + (16 * tt + j) * 8); val = (O[tt][n][j] - ms[0]) * ms[1] * wgt; }
                            LAS bf16_t* sp = (LAS bf16_t*)(lds + stb + ((16 * tt + j) * VS + 16 * n) * 2);
                            *sp = (bf16_t)f2bf(val * bf2f(*sp));
                        }
                    }
                }
            }
            __syncthreads();
            if (!(c == 0 && b == 1)) {
                const int rowbase = (c == 0) ? (MMAIN - 48) : (b * SEQ + (c - 1) * 64);
#pragma unroll
                for (int i = 0; i < 4; ++i) {
                    const int t = (tid >> 5) + 16 * i;
                    if (c > 0 || t >= 48) *(u32x4*)(Y + (size_t)(rowbase + t) * 2048 + yc + 8 * (tid & 31)) = *(const LAS u32x4*)(lds + (t * VS + 8 * (tid & 31)) * 2);
                }
            }
        }
    }
    if (Sout) {
#pragma unroll
        for (int m = 0; m < 8; ++m)
#pragma unroll
            for (int n = 0; n < NT; ++n)
#pragma unroll
                for (int j = 0; j < 4; ++j) Sout[(size_t)(16 * m + 4 * fq + j) * NCOL + dvw + 16 * n + fr] = S[m][n][j];
    }
    if (MODE == 2 && PASS == 1 && Gout) { if (lane == 0 && (wid & 1) == 0) Gout[hl] = Gacc; }
}

constexpr int SEG0 = 12, NSEG0 = 11;
constexpr int SEG1 = 9, NSEG1 = 15;
__device__ __forceinline__ void gdn_chain(LAS uchar* lds, float* Q, const float* Pm, const int half, const int tid) {
    const int wid = __builtin_amdgcn_readfirstlane(tid >> 6), lane = tid & 63, fr = lane & 15, fq = lane >> 4, dvw = half * 128 + 16 * wid;
    f32x4 S[8];
#pragma unroll
    for (int m = 0; m < 8; ++m) S[m] = (f32x4){0.f, 0.f, 0.f, 0.f};
    f32x4 pp[8];
    {
        int tl0 = tid; asm volatile("" : "+v"(tl0));
#pragma unroll
        for (int i = 0; i < 8; ++i) { const int idx = tl0 + 512 * i; pp[i] = *(const f32x4*)(Pm + (idx >> 5) * 128 + 4 * (idx & 31)); }
    }
#pragma unroll 1
    for (int j = 0; j < NSEG0 - 1; ++j) {
        __syncthreads();
        int tl = tid; asm volatile("" : "+v"(tl));
#pragma unroll
        for (int i = 0; i < 8; ++i) {
            const int idx = tl + 512 * i, row = idx >> 5, c4 = idx & 31;
            u32x2 o = {cvt_pk_bf16(pp[i][0], pp[i][1]), cvt_pk_bf16(pp[i][2], pp[i][3])};
            *(LAS u32x2*)(lds + (row * QS + 4 * c4) * 2) = o;
        }
        if (j + 1 < NSEG0 - 1) {
            const float* Pn = Pm + (size_t)(j + 1) * 16384;
#pragma unroll
            for (int i = 0; i < 8; ++i) { const int idx = tl + 512 * i; pp[i] = *(const f32x4*)(Pn + (idx >> 5) * 128 + 4 * (idx & 31)); }
        }
        float* Qj = Q + (size_t)j * 32768 + (size_t)(4 * fq) * 256 + dvw + fr;
        f32x4 Qv[8];
#pragma unroll
        for (int m = 0; m < 8; ++m)
#pragma unroll
            for (int jj = 0; jj < 4; ++jj) Qv[m][jj] = Qj[(16 * m + jj) * 256];
        __syncthreads();
        f32x4 Sn[8];
#pragma unroll
        for (int m = 0; m < 8; ++m) Sn[m] = (f32x4){0.f, 0.f, 0.f, 0.f};
        LB(pb, (fr * QS + 4 * fq) * 2);
#pragma unroll
        for (int ks = 0; ks < 4; ++ks) {
            const bf16x8 b0 = pack8(S[2 * ks], S[2 * ks + 1]);
#pragma unroll
            for (int m = 0; m < 8; ++m) {
                const LAS uchar* ap = lds + pb + (16 * m * QS + 32 * ks) * 2;
                const bf16x8 a = mk8(*(const LAS u32x2*)ap, *(const LAS u32x2*)(ap + 32));
                Sn[m] = MFMA16(a, b0, Sn[m]);
            }
        }
#pragma unroll
        for (int m = 0; m < 8; ++m)
#pragma unroll
            for (int jj = 0; jj < 4; ++jj) { const float v = Sn[m][jj] + Qv[m][jj]; S[m][jj] = v; Qj[(16 * m + jj) * 256] = v; }
    }
}

#define XB_TMO      128
#define XB_XCNT(j)  (256  + 64 * (j))
#define XB_XSUB(j)  (1280 + 64 * (j))
#define XB_XGEN(j)  (2304 + 64 * (j))
#define XB_TOP      3328
#define XB_TOPGEN   3392
#define XCD_BAR_WORDS 3456
#define XB_SPIN_CAP (1u << 18)

__device__ __forceinline__ unsigned xb_ld(unsigned* p)              { return __hip_atomic_load(p, __ATOMIC_RELAXED, __HIP_MEMORY_SCOPE_AGENT); }
__device__ __forceinline__ unsigned xb_add(unsigned* p, unsigned v) { return __hip_atomic_fetch_add(p, v, __ATOMIC_RELAXED, __HIP_MEMORY_SCOPE_AGENT); }
__device__ __forceinline__ unsigned xb_xcc_id() { return (unsigned)__builtin_amdgcn_s_getreg((3 << 11) | 20) & 0xFu; }
#define XB_SPIN(cond, bar) do { unsigned _sp = 0; while (cond) { __builtin_amdgcn_s_sleep(1); \
    if ((++_sp & 255u) == 0u) { if (xb_ld(&(bar)[XB_TMO])) break; if (_sp > XB_SPIN_CAP) { atomicAdd(&(bar)[XB_TMO], 1u); break; } } } } while (0)

struct XcdBarrier {
    unsigned* bar; unsigned x;
    volatile LAS unsigned* st;
};

__device__ __forceinline__ XcdBarrier xcd_barrier_post(unsigned* bar, volatile LAS unsigned* st) {
    XcdBarrier b; b.bar = bar; b.x = xb_xcc_id(); b.st = st;
    if (threadIdx.x == 0) (void)xb_add(&bar[XB_XCNT(b.x)], 1u);
    return b;
}
__device__ __forceinline__ void xcd_barrier_complete(unsigned* bar, unsigned x, unsigned& nloc, unsigned& nx) {
    const unsigned G = gridDim.x * gridDim.y * gridDim.z;
    unsigned sum, cnt, mine, sp = 0u;
    for (;;) {
        sum = 0u; cnt = 0u; mine = 0u;
#pragma unroll
        for (unsigned j = 0; j < 16; ++j) { const unsigned c = xb_ld(&bar[XB_XCNT(j)]); sum += c; cnt += (c > 0u) ? 1u : 0u; mine = (j == x) ? c : mine; }
        if (sum == G) break;
        __builtin_amdgcn_s_sleep(1);
        if ((++sp & 255u) == 0u) { if (xb_ld(&bar[XB_TMO])) break; if (sp > XB_SPIN_CAP) { atomicAdd(&bar[XB_TMO], 1u); break; } }
    }
    nloc = mine > 0u ? mine : 1u; nx = cnt > 0u ? cnt : 1u;
}

__device__ __forceinline__ void xcd_barrier(const XcdBarrier& b) {
    asm volatile("s_waitcnt vmcnt(0)" ::: "memory");
    __syncthreads();
    if (threadIdx.x == 0) {
        unsigned* bar = b.bar;
        __builtin_amdgcn_s_waitcnt(0);
        unsigned nloc = b.st[0], nx = b.st[1];
        if (nloc == 0u) { xcd_barrier_complete(bar, b.x, nloc, nx); b.st[0] = nloc; b.st[1] = nx; }
        const unsigned old = xb_add(&bar[XB_XSUB(b.x)], 1u);
        const unsigned gen = old / nloc;
        if (old + 1u == (gen + 1u) * nloc) {
            __builtin_amdgcn_fence(__ATOMIC_RELEASE, "agent");
            asm volatile("s_waitcnt vmcnt(0)" ::: "memory");
            const unsigned og = xb_add(&bar[XB_TOP], 1u);
            const unsigned tg = og / nx;
            if (og + 1u == (tg + 1u) * nx) xb_add(&bar[XB_TOPGEN], 1u);
            else XB_SPIN(xb_ld(&bar[XB_TOPGEN]) == tg, bar);
            __builtin_amdgcn_fence(__ATOMIC_ACQUIRE, "agent");
            xb_add(&bar[XB_XGEN(b.x)], 1u);
            asm volatile("s_waitcnt vmcnt(0)" ::: "memory");
        } else {
            XB_SPIN(xb_ld(&bar[XB_XGEN(b.x)]) == gen, bar);
            __builtin_amdgcn_fence(__ATOMIC_ACQUIRE, "agent");
            asm volatile("s_waitcnt vmcnt(0)" ::: "memory");
        }
    }
    __syncthreads();
}


template <int SRC, bool WRITE_HB> struct EpiLN {
    static constexpr bool AFTER_DRAIN = true;
    float* Rm; const float* x; const float* lnw; const float* lnb; bf16_t* hb; f32x2* stats;
    __device__ __forceinline__ void fused(f32x4 (&acc)[2][2][4][2], const pg8::Unit& u, int wr, int wc, int fr, int fq, LAS uchar* lds, const int tid, const XcdBarrier& xbar) const {
        LAS f32x2* PT = (LAS f32x2*)lds;
        LAS f32x2* ST = (LAS f32x2*)(lds + 8192);
        const int row0 = u.pm * 256 + wr * 64 + fr, colt = u.pn * 256 + wc * 32 + 8 * fq;
#pragma unroll
        for (int ai = 0; ai < 2; ++ai) {
            f32x4 hv[4][2][2];
#pragma unroll
            for (int m = 0; m < 4; ++m) {
                const float* hp = (SRC == 0 ? x : Rm) + (size_t)(row0 + ai * 128 + m * 16) * DM + colt;
#pragma unroll
                for (int bj = 0; bj < 2; ++bj) { hv[m][bj][0] = *(const f32x4*)(hp + bj * 128); hv[m][bj][1] = *(const f32x4*)(hp + bj * 128 + 4); }
            }
#pragma unroll
            for (int m = 0; m < 4; ++m) {
                float s1 = 0.f, s2 = 0.f;
#pragma unroll
                for (int bj = 0; bj < 2; ++bj) {
                    const f32x4 v0 = hv[m][bj][0] * DN_ALPHA + acc[ai][bj][m][0], v1 = hv[m][bj][1] * DN_ALPHA + acc[ai][bj][m][1];
                    acc[ai][bj][m][0] = v0; acc[ai][bj][m][1] = v1;
#pragma unroll
                    for (int e = 0; e < 4; ++e) { s1 += v0[e] + v1[e]; s2 += v0[e] * v0[e] + v1[e] * v1[e]; }
                }
                s1 += __shfl_xor(s1, 16); s1 += __shfl_xor(s1, 32); s2 += __shfl_xor(s2, 16); s2 += __shfl_xor(s2, 32);
                if (fq == 0) PT[(ai * 128 + wr * 64 + m * 16 + fr) * 4 + wc] = (f32x2){s1, s2};
            }
            __builtin_amdgcn_sched_barrier(0);
        }
        __syncthreads();
        if (tid < 256) {
            const f32x2 a = PT[tid * 4 + 0], b = PT[tid * 4 + 1], c = PT[tid * 4 + 2], d = PT[tid * 4 + 3];
            stats[(size_t)(u.pm * 256 + tid) * 4 + u.pn] = (f32x2){(a[0] + b[0]) + (c[0] + d[0]), (a[1] + b[1]) + (c[1] + d[1])};
        }
        xcd_barrier(xbar);
        if (tid < 256) {
            const f32x2* sp = stats + (size_t)(u.pm * 256 + tid) * 4;
            const f32x2 a = sp[0], b = sp[1], c = sp[2], d = sp[3];
            const float mean = ((a[0] + b[0]) + (c[0] + d[0])) * (1.f / DM);
            const float var = fmaxf(((a[1] + b[1]) + (c[1] + d[1])) * (1.f / DM) - mean * mean, 0.f);
            ST[tid] = (f32x2){mean, 1.f / sqrtf(var + 1e-5f)};
        }
        __syncthreads();
        f32x4 wv[2][2], bv[2][2];
#pragma unroll
        for (int bj = 0; bj < 2; ++bj)
#pragma unroll
            for (int n = 0; n < 2; ++n) { wv[bj][n] = *(const f32x4*)(lnw + colt + bj * 128 + 4 * n); bv[bj][n] = *(const f32x4*)(lnb + colt + bj * 128 + 4 * n); }
#pragma unroll
        for (int ai = 0; ai < 2; ++ai)
#pragma unroll
            for (int m = 0; m < 4; ++m) {
                const int rl = ai * 128 + wr * 64 + m * 16 + fr, row = u.pm * 256 + rl;
                const f32x2 ms = ST[rl];
                float* rp = Rm + (size_t)row * DM + colt;
#pragma unroll
                for (int bj = 0; bj < 2; ++bj) {
                    const f32x4 y0 = (acc[ai][bj][m][0] - ms[0]) * ms[1] * wv[bj][0] + bv[bj][0], y1 = (acc[ai][bj][m][1] - ms[0]) * ms[1] * wv[bj][1] + bv[bj][1];
                    *(f32x4*)(rp + bj * 128) = y0; *(f32x4*)(rp + bj * 128 + 4) = y1;
                    if (WRITE_HB) { u32x4 w = {cvt_pk_bf16(y0[0], y0[1]), cvt_pk_bf16(y0[2], y0[3]), cvt_pk_bf16(y1[0], y1[1]), cvt_pk_bf16(y1[2], y1[3])}; *(u32x4*)(hb + (size_t)row * DM + colt + bj * 128) = w; }
                }
                __builtin_amdgcn_sched_barrier(0);
            }
    }
};
__device__ __forceinline__ void ln_tail_row(float* rp, const float* w, const float* bia, bf16_t* hbrow, const int lane) {
    f32x4 v[4]; float s = 0.f;
#pragma unroll
    for (int j = 0; j < 4; ++j) { v[j] = ((const f32x4*)rp)[lane + 64 * j]; s += (v[j][0] + v[j][1]) + (v[j][2] + v[j][3]); }
    const float mean = wave_sum(s) * (1.f / DM); float s2 = 0.f;
#pragma unroll
    for (int j = 0; j < 4; ++j) { v[j] = v[j] - mean; s2 += (v[j][0] * v[j][0] + v[j][1] * v[j][1]) + (v[j][2] * v[j][2] + v[j][3] * v[j][3]); }
    const float rstd = 1.f / sqrtf(wave_sum(s2) * (1.f / DM) + 1e-5f);
#pragma unroll
    for (int j = 0; j < 4; ++j) {
        const f32x4 y = v[j] * rstd * ((const f32x4*)w)[lane + 64 * j] + ((const f32x4*)bia)[lane + 64 * j];
        ((f32x4*)rp)[lane + 64 * j] = y;
        u32x2 o = {cvt_pk_bf16(y[0], y[1]), cvt_pk_bf16(y[2], y[3])}; ((u32x2*)hbrow)[lane + 64 * j] = o;
    }
}

__global__ void __launch_bounds__(NTHREADS, 2) mega_fwd(Params p) {
    extern __shared__ __attribute__((aligned(16))) uchar lds_raw[];
    LAS uchar* lds = (LAS uchar*)lds_raw;
    cg::grid_group grid = cg::this_grid();
    const int bid = blockIdx.x, nb = gridDim.x;
    const int wave0 = __builtin_amdgcn_readfirstlane((int)threadIdx.x >> 6);
    volatile LAS unsigned* MISC = (volatile LAS unsigned*)(lds + 131072);
    if (threadIdx.x < 2) MISC[threadIdx.x] = 0u;
    __syncthreads();
    const XcdBarrier xb = xcd_barrier_post((unsigned*)(p.ws + OFF_BAR), MISC);
#define GSYNC() xcd_barrier(xb)
#define PHASE_VARS \
    int tid; asm volatile("v_mbcnt_lo_u32_b32 %0, -1, 0\n\tv_mbcnt_hi_u32_b32 %0, -1, %0" : "=v"(tid)); tid += wave0 * 64; \
    uchar* ws = p.ws; asm volatile("" : "+s"(ws)); int nbl = nb; asm volatile("" : "+s"(nbl)); (void)nbl; \
    float* Rm = p.out; asm volatile("" : "+s"(Rm)); \
    bf16_t* HB = (bf16_t*)(ws + OFF_HB); bf16_t* Yb = (bf16_t*)(ws + OFF_Y); bf16_t* Pb = (bf16_t*)(ws + OFF_P); \
    bf16_t* WA = (bf16_t*)(ws + OFF_WA); bf16_t* WO = (bf16_t*)(ws + OFF_WOUT); bf16_t* WSM = (bf16_t*)(ws + OFF_WSM); \
    bf16_t* W1t = (bf16_t*)(ws + OFF_TINV); bf16_t* W2t = (bf16_t*)(ws + OFF_WA); f32x2* lnstats = (f32x2*)(ws + OFF_SIDE); \
    float* Rt = (float*)(ws + OFF_RT); float* side = (float*)(ws + OFF_SIDE); \
    (void)HB; (void)Yb; (void)Pb; (void)WA; (void)WO; (void)WSM; (void)W1t; (void)W2t; (void)lnstats; (void)Rt; (void)side; (void)Rm;
    const int lo = p.ph_lo, hi = p.ph_hi;
#define IN(k) (lo <= (k) && (k) < hi)
#define REPEAT(n) for (int rep_ = 0; rep_ < (n); ++rep_, (rep_ < (n) ? GSYNC() : (void)0))
#define SEAM(k) do { if (IN(k) && IN((k) + 1)) GSYNC(); } while (0)
    if (lo > hi) grid.sync();

    if (IN(0)) REPEAT(REP0) {
        PHASE_VARS
        {
            const int lane = tid & 63, gw = bid * 8 + (tid >> 6), NGW = nb * 8;
            for (int row = gw; row < MROWS; row += NGW) {
                const float* xp = row < MMAIN ? p.in[I_X] + (size_t)row * DM : p.in[I_META] + (size_t)(row - MMAIN) * DM;
#pragma unroll
                for (int j = 0; j < 4; ++j) { const f32x4 v = ((const f32x4*)xp)[lane + 64 * j]; u32x2 o = {cvt_pk_bf16(v[0], v[1]), cvt_pk_bf16(v[2], v[3])}; ((u32x2*)(HB + (size_t)row * DM))[lane + 64 * j] = o; }
            }
        }
        {
            const float* w = p.in[I_ABWIN];
            const TSeg segs[5] = {{w, 6152, 0, 2048, 1024, WA, 0}, {w, 6152, 3072, 2048, 1024, WA, 2048}, {w, 6152, 2048, 1024, 1024, WA, 4096}, {w, 6152, 5128, 1024, 1024, WA, 5120},
                                  {p.in[I_ABWOUT], 1024, 0, 1024, 2048, WO, 0}};
            transpose_segs<5>(lds, segs, tid);
        }
        for (int i = bid * NTHREADS + tid; i < 32 * 1024; i += nbl * NTHREADS) {
            const int r = i >> 10, k = i & 1023;
            WSM[i] = r < 8 ? (bf16_t)f2bf(p.in[I_ABWIN][(size_t)k * 6152 + 5120 + r]) : (bf16_t)0;
        }
        for (int i = bid * NTHREADS + tid; i < 8256 * 64; i += nbl * NTHREADS) {
            const int L = i >> 6, d = i & 63;
            const float pos = (float)(L - 48);
            const float invf = 1.0f / powf(10000.0f, (float)d * (1.0f / 63.0f));
            const float ang = pos * invf;
            const double ad = (double)ang; const double kk = rint(ad * 0.15915494309189535); const double r = ad - kk * 6.283185307179586;
            float sn, cs; __sincosf((float)r, &sn, &cs);
            ((f32x2*)(ws + OFF_CS))[i] = (f32x2){cs, sn};
        }
    }
    SEAM(0);
    if (IN(1)) REPEAT(REP1) {
        PHASE_VARS
        Epi<0> E{Pb, 4096, 4096, Yb, 2048, nullptr, nullptr, nullptr, nullptr, nullptr};
        Epi<4> Es{nullptr, 0, 0, nullptr, 0, nullptr, nullptr, nullptr, nullptr, side};
        skinny_gemm<1>(lds, HB, DM, WA, DM, MMAIN, 1, 6144 / 32, E, bid, nb, tid);
        skinny_gemm<4>(lds, HB, DM, WSM, DM, 0, MROWS / 16, 1, Es, bid, nb, tid);
        pg8::Gemm g{HB, WA, MMAIN, 6144, DM}; pg8::StaticOrder S; S.init(MMAIN, 6144, nb, bid);
#ifndef NO_GEMM
        pg8::gemm_phase(lds, g, S, E, tid, xb);
#endif
    }
    SEAM(1);
#ifndef NO_TINV
    if (IN(2)) {
        { PHASE_VARS halo_save(Pb, 4096, 2048, 256, HB, tid); }
        GSYNC();
        { PHASE_VARS conv_inplace<0>(Pb, 4096, 2048, 256, HB, p, tid); rope_inplace(Pb, ws, tid); }
        GSYNC();
        REPEAT(REP2) { PHASE_VARS tinv_phase(lds, p, ws, tid); }
    }
#endif
    SEAM(2);
    if (IN(3)) REPEAT(REP3) {
        PHASE_VARS
        float* RQ = (float*)(ws + OFF_HB); float* GQ = RQ + 8 * 10 * 32768; float* GP = GQ + 8 * 10 * 32768;
        for (int u = bid; u < 240; u += nb) {
            const int kind = u / 80, r = u % 80, unit = r / 10, seg = r % 10, b = unit >> 2, h = unit & 3, c0 = seg * SEG0, c1 = c0 + SEG0;
            if (kind == 0) { int tid2 = tid; asm volatile("" : "+v"(tid2)); scan_unit<0, 1, 2>(lds, p, ws, b, h, c0, c1, nullptr, RQ + (size_t)(unit * 10 + seg) * 32768, nullptr, tid2); }
            else if (kind == 1) { int tid2 = tid; asm volatile("" : "+v"(tid2)); scan_unit<1, 1, 2>(lds, p, ws, b, h, c0, c1, nullptr, GQ + (size_t)(unit * 10 + seg) * 32768, nullptr, tid2); }
            else { int tid2 = tid; asm volatile("" : "+v"(tid2)); scan_unit<3, 1, 1>(lds, p, ws, b, h, c0, c1, nullptr, GP + (size_t)(unit * 10 + seg) * 16384, nullptr, tid2); }
        }
    }
    SEAM(3);
    if (IN(4)) {
        PHASE_VARS
        float* RQ = (float*)(ws + OFF_HB); float* GQ = RQ + 8 * 10 * 32768; float* GP = GQ + 8 * 10 * 32768;
        if (bid < 16) gdn_chain(lds, GQ + (size_t)(bid >> 1) * 10 * 32768, GP + (size_t)(bid >> 1) * 10 * 16384, bid & 1, tid);
        else {
            for (int e = (bid - 16) * NTHREADS + tid; e < 8 * 32768 / 4; e += (nbl - 16) * NTHREADS) {
                const int unit = e >> 13, off = (e & 8191) * 4;
                const float d = __expf(log1pf(-exp2f(-5.f - (float)(unit & 3))) * (64.f * SEG0));
                float* q = RQ + (size_t)unit * 10 * 32768 + off;
                f32x4 qv[NSEG0 - 1];
#pragma unroll
                for (int j = 0; j < NSEG0 - 1; ++j) qv[j] = *(const f32x4*)(q + (size_t)j * 32768);
                f32x4 S = {0.f, 0.f, 0.f, 0.f};
#pragma unroll
                for (int j = 0; j < NSEG0 - 1; ++j) { S = S * d + qv[j]; *(f32x4*)(q + (size_t)j * 32768) = S; }
            }
        }
    }
    SEAM(4);
    if (IN(5)) {
        PHASE_VARS
        float* RQ = (float*)(ws + OFF_HB); float* GQ = RQ + 8 * 10 * 32768;
        for (int u = bid; u < 256; u += nb) {
            if (u < 88) {
                const int unit = u / NSEG0, seg = u % NSEG0, b = unit >> 2, h = unit & 3, c0 = seg * SEG0, c1 = (c0 + SEG0 < NCHUNK) ? c0 + SEG0 : NCHUNK;
                int tid2 = tid; asm volatile("" : "+v"(tid2));
                scan_unit<0, 0, 2, false, true, true>(lds, p, ws, b, h, c0, c1, seg > 0 ? RQ + (size_t)(unit * 10 + seg - 1) * 32768 : nullptr, nullptr, nullptr, tid2);
            } else {
                int unit, seg, c0, c1, cfull;
                if (u < 248) { const int idx = (u - 88) % 80, half = (u - 88) / 80; unit = idx / 10; seg = idx % 10; c0 = seg * SEG0; c1 = half ? c0 + SEG0 : c0 + SEG0 / 2; cfull = half ? c0 + SEG0 / 2 : c0; }
                else { unit = u - 248; seg = 10; c0 = seg * SEG0; c1 = NCHUNK; cfull = c0; }
                int tid2 = tid; asm volatile("" : "+v"(tid2));
                scan_unit<1, 0, 2, true, true, false>(lds, p, ws, unit >> 2, unit & 3, c0, c1, seg > 0 ? GQ + (size_t)(unit * 10 + seg - 1) * 32768 : nullptr, nullptr, nullptr, tid2, cfull);
            }
        }
    }
    SEAM(5);
    if (IN(6)) {
        PHASE_VARS
        {
            const TSeg segs[2] = {{p.in[I_W1], DFF, 0, DFF, DM, W1t, 0}, {p.in[I_W2], DM, 0, DM, DFF, W2t, 0}};
            transpose_segs<2>(lds, segs, tid);
        }
        __syncthreads();
        Epi<2> Et{nullptr, 0, 0, nullptr, 0, Rm, Rt, p.in[I_X], p.in[I_META], nullptr};
        skinny_gemm<1>(lds, Yb, 2048, WO, 2048, MMAIN, 1, DM / 32, Et, bid, nb, tid);
        EpiLN<0, true> E{Rm, p.in[I_X], p.in[I_LN1W], p.in[I_LN1B], HB, lnstats};
        pg8::Gemm g{Yb, WO, MMAIN, DM, 2048}; pg8::StaticOrder S; S.init(MMAIN, DM, nb, bid);
        pg8::gemm_phase(lds, g, S, E, tid, xb);
        if (bid < 16 && tid < 64) ln_tail_row(Rt + (size_t)bid * DM, p.in[I_LN1W], p.in[I_LN1B], HB + (size_t)(MMAIN + bid) * DM, tid);
    }
    SEAM(6);
#pragma unroll
    for (int layer = 0; layer < 2; ++layer) {
        const int pb = layer == 0 ? 7 : 17;
        if (IN(pb + 1)) {
            PHASE_VARS
            Epi<1> E{Pb, DFF, 0, nullptr, 0, nullptr, nullptr, nullptr, nullptr, nullptr};
            skinny_gemm<1>(lds, HB, DM, W1t, DM, MMAIN, 1, DFF / 32, E, bid, nb, tid);
            pg8::Gemm g{HB, W1t, MMAIN, DFF, DM}; pg8::StaticOrder S; S.init(MMAIN, DFF, nb, bid);
            pg8::gemm_phase(lds, g, S, E, tid, xb);
        }
        SEAM(pb + 1);
        if (IN(pb + 2)) {
            PHASE_VARS
            pg8::Gemm g{Pb, W2t, MMAIN, DM, DFF}; pg8::StaticOrder S; S.init(MMAIN, DM, nb, bid);
            if (layer == 0) {
                Epi<3> Et{nullptr, 0, 0, nullptr, 0, Rm, Rt, nullptr, nullptr, nullptr};
                skinny_gemm<1>(lds, Pb, DFF, W2t, DFF, MMAIN, 1, DM / 32, Et, bid, nb, tid);
                EpiLN<1, true> E{Rm, nullptr, p.in[I_LN2W], p.in[I_LN2B], HB, lnstats};
                pg8::gemm_phase(lds, g, S, E, tid, xb);
                if (bid < 16 && tid < 64) ln_tail_row(Rt + (size_t)bid * DM, p.in[I_LN2W], p.in[I_LN2B], HB + (size_t)(MMAIN + bid) * DM, tid);
                {
                    __syncthreads();
                    int tid3 = tid; asm volatile("" : "+v"(tid3));
                    const float* w = p.in[I_CWIN];
                    const TSeg segs[3] = {{w, 5152, 2048, 3072, 1024, WA, 0}, {w, 5152, 0, 2048, 1024, WA, 3072}, {p.in[I_CWOUT], 1024, 0, 1024, 2048, WO, 0}};
                    transpose_segs<3>(lds, segs, tid3);
                    for (int i = bid * NTHREADS + tid3; i < 32 * 1024; i += nbl * NTHREADS) { const int r = i >> 10, k = i & 1023; WSM[i] = (bf16_t)f2bf(w[(size_t)k * 5152 + 5120 + r]); }
                }
            } else {
                EpiLN<1, false> E{Rm, nullptr, p.in[I_LN2W] + DM, p.in[I_LN2B] + DM, HB, lnstats};
                pg8::gemm_phase(lds, g, S, E, tid, xb);
            }
        }
        SEAM(pb + 2);
        if (layer == 0) {
            if (IN(11)) REPEAT(REP11) {
                PHASE_VARS
                Epi<0> E{Pb, 3072, 3072, Yb, 2048, nullptr, nullptr, nullptr, nullptr, nullptr};
                Epi<4> Es{nullptr, 0, 0, nullptr, 0, nullptr, nullptr, nullptr, nullptr, side};
                skinny_gemm<1>(lds, HB, DM, WA, DM, MMAIN, 1, 5120 / 32, E, bid, nb, tid);
                skinny_gemm<4>(lds, HB, DM, WSM, DM, 0, MROWS / 16, 1, Es, bid, nb, tid);
                pg8::Gemm g{HB, WA, MMAIN, 5120, DM}; pg8::StaticOrder S; S.init(MMAIN, 5120, nb, bid);
                pg8::gemm_phase(lds, g, S, E, tid, xb);
            }
            SEAM(11);
            if (IN(12)) {
                { PHASE_VARS halo_save(Pb, 3072, 0, 384, HB, tid); }
                GSYNC();
                { PHASE_VARS conv_inplace<1>(Pb, 3072, 0, 384, HB, p, tid); }
                GSYNC();
            }
            if (IN(12)) REPEAT(REP12) {
                PHASE_VARS
                float* SQ = (float*)(ws + OFF_HB); float* SG = SQ + (size_t)16 * 14 * 32768;
                for (int u = bid; u < 224; u += nb) {
                    const int unit = u / 14, seg = u % 14, c0 = seg * SEG1;
                    int tid2 = tid; asm volatile("" : "+v"(tid2));
                    scan_unit<2, 1, 2>(lds, p, ws, unit >> 3, unit & 7, c0, c0 + SEG1, nullptr, SQ + (size_t)(unit * 14 + seg) * 32768, SG + (unit * 14 + seg) * 4, tid2);
                }
            }
            SEAM(12);
            if (IN(13)) {
                PHASE_VARS
                float* SQ = (float*)(ws + OFF_HB); float* SG = SQ + (size_t)16 * 14 * 32768;
                for (int e = bid * NTHREADS + tid; e < 16 * 32768 / 4; e += nbl * NTHREADS) {
                    const int unit = e >> 13, off = (e & 8191) * 4, hq = (off & 255) >> 6;
                    float* q = SQ + (size_t)unit * 14 * 32768 + off;
                    f32x4 qv[NSEG1 - 1]; float dg[NSEG1 - 1];
#pragma unroll
                    for (int j = 0; j < NSEG1 - 1; ++j) { qv[j] = *(const f32x4*)(q + (size_t)j * 32768); dg[j] = SG[(unit * 14 + j) * 4 + hq]; }
                    f32x4 S = {0.f, 0.f, 0.f, 0.f};
#pragma unroll
                    for (int j = 0; j < NSEG1 - 1; ++j) { S = S * __expf(dg[j]) + qv[j]; *(f32x4*)(q + (size_t)j * 32768) = S; }
                }
            }
            SEAM(13);
            if (IN(14)) {
                PHASE_VARS
                float* SQ = (float*)(ws + OFF_HB);
                for (int u = bid; u < 240; u += nb) {
                    const int unit = u / NSEG1, seg = u % NSEG1, c0 = seg * SEG1, c1 = (c0 + SEG1 < NCHUNK) ? c0 + SEG1 : NCHUNK;
                    int tid2 = tid; asm volatile("" : "+v"(tid2));
                    scan_unit<2, 0, 2>(lds, p, ws, unit >> 3, unit & 7, c0, c1, seg > 0 ? SQ + (size_t)(unit * 14 + seg - 1) * 32768 : nullptr, nullptr, nullptr, tid2);
                }
            }
            SEAM(14);
            if (IN(15)) { PHASE_VARS rmsnorm_phase(Yb, p.in[I_CNORMW], tid); }
            SEAM(15);
            if (IN(16)) {
                PHASE_VARS
                {
                    const TSeg segs[2] = {{p.in[I_W1] + (size_t)DM * DFF, DFF, 0, DFF, DM, W1t, 0}, {p.in[I_W2] + (size_t)DM * DFF, DM, 0, DM, DFF, W2t, 0}};
                    transpose_segs<2>(lds, segs, tid);
                }
                __syncthreads();
                Epi<3> Et{nullptr, 0, 0, nullptr, 0, Rm, Rt, nullptr, nullptr, nullptr};
                skinny_gemm<1>(lds, Yb, 2048, WO, 2048, MMAIN, 1, DM / 32, Et, bid, nb, tid);
                EpiLN<1, true> E{Rm, nullptr, p.in[I_LN1W] + DM, p.in[I_LN1B] + DM, HB, lnstats};
                pg8::Gemm g{Yb, WO, MMAIN, DM, 2048}; pg8::StaticOrder S; S.init(MMAIN, DM, nb, bid);
                pg8::gemm_phase(lds, g, S, E, tid, xb);
                if (bid < 16 && tid < 64) ln_tail_row(Rt + (size_t)bid * DM, p.in[I_LN1W] + DM, p.in[I_LN1B] + DM, HB + (size_t)(MMAIN + bid) * DM, tid);
            }
            SEAM(16);
        }
    }
#undef IN
#undef SEAM
}

#ifndef MK_PER_PHASE
#define MK_PER_PHASE 0
#endif
extern "C" void kernel_launch(void* const* d_in, const int* in_sizes, int n_in, void* d_out, int out_size, void* d_ws, size_t ws_size, hipStream_t stream) {
    static int grid = 0;
    if (grid == 0) {
        if (n_in != 25 || ws_size < WS_END || out_size != MMAIN * DM) { fprintf(stderr, "kernel_launch: unexpected shapes (n_in %d ws %zu out %d)\n", n_in, ws_size, out_size); grid = -1; return; }
        int dev = 0, cus = 0, per_cu = 0;
        hipGetDevice(&dev);
        hipDeviceGetAttribute(&cus, hipDeviceAttributeMultiprocessorCount, dev);
        if (hipFuncSetAttribute((const void*)mega_fwd, hipFuncAttributeMaxDynamicSharedMemorySize, LDS_BYTES) != hipSuccess) { fprintf(stderr, "kernel_launch: hipFuncSetAttribute failed\n"); grid = -1; return; }
        if (hipOccupancyMaxActiveBlocksPerMultiprocessor(&per_cu, (const void*)mega_fwd, NTHREADS, LDS_BYTES) != hipSuccess || per_cu < 1) { fprintf(stderr, "kernel_launch: occupancy query says %d\n", per_cu); grid = -1; return; }
        grid = cus * (per_cu > 1 ? 1 : per_cu);
        fprintf(stderr, "kernel_launch: grid %d (cus %d per_cu %d)\n", grid, cus, per_cu);
    }
    if (grid < 0) return;
    if (hipMemsetAsync((char*)d_ws + OFF_BAR, 0, 16384, stream) != hipSuccess) { fprintf(stderr, "kernel_launch: memset failed\n"); return; }
    Params p{};
    for (int i = 0; i < 25; ++i) p.in[i] = (const float*)d_in[i];
    p.out = (float*)d_out; p.ws = (uchar*)d_ws;
#if MK_PER_PHASE
    for (int ph = 0; ph < 21; ++ph) {
        p.ph_lo = ph; p.ph_hi = ph + 1;
        void* args[] = {&p};
        hipError_t e = hipLaunchCooperativeKernel((const void*)mega_fwd, dim3(grid), dim3(NTHREADS), args, LDS_BYTES, stream);
        if (e != hipSuccess) { fprintf(stderr, "cooperative launch failed: %s\n", hipGetErrorString(e)); break; }
    }
#else
    p.ph_lo = 0; p.ph_hi = 20;
    void* args[] = {&p};
    hipError_t e = hipLaunchCooperativeKernel((const void*)mega_fwd, dim3(grid), dim3(NTHREADS), args, LDS_BYTES, stream);
    if (e != hipSuccess) fprintf(stderr, "cooperative launch failed: %s (grid %d)\n", hipGetErrorString(e), grid);
#endif
}
```

```cpp
#include <hip/hip_runtime.h>
#include <hip/hip_cooperative_groups.h>
#include <cstdio>
#include <cstdint>
namespace cg = cooperative_groups;

#define LAS __attribute__((address_space(3)))
typedef unsigned short bf16_t;
typedef short bf16x8 __attribute__((ext_vector_type(8)));
typedef float f32x4 __attribute__((ext_vector_type(4)));
typedef float f32x2 __attribute__((ext_vector_type(2)));
typedef unsigned u32x4 __attribute__((ext_vector_type(4)));
typedef unsigned u32x2 __attribute__((ext_vector_type(2)));
typedef unsigned char uchar;

constexpr int DM = 1024, SEQ = 8192, MMAIN = 16384, MROWS = 16400, NCHUNK = 129, DFF = 4096;
constexpr float DN_ALPHA = 1.41421356237309515f;
constexpr int NTHREADS = 512;
#define REP1 1
#define REP0 1
#define REPT 1
#define REP2 1
#define REP3 1
#define REP8 1
#define REP11 1
#define REP12 1
constexpr int LDS_BYTES = 133120;

constexpr size_t OFF_CS = 0;
constexpr size_t OFF_SIDE = 4227072;
constexpr size_t OFF_RT = 6326272;
constexpr size_t OFF_WSM = 6391808;
constexpr size_t OFF_TINV = 6457344;
constexpr size_t OFF_HB = 14911488;
constexpr size_t OFF_Y = 48498688;
constexpr size_t OFF_P = 115673088;
constexpr size_t OFF_WA = 250021888;
constexpr size_t OFF_WOUT = OFF_WA + 12582912;
constexpr size_t WS_END = OFF_WA + 16777216 + 16384;
constexpr size_t OFF_BAR = OFF_WA + 16777216;

struct Params {
    const float* in[25];
    float* out;
    uchar* ws;
    int ph_lo, ph_hi;
};
enum { I_X = 0, I_META, I_ABWIN, I_RETGN, I_CONVQ, I_CONVK, I_CONVV, I_ABALOG, I_ABDTB, I_GDNNW, I_ABWOUT, I_CWIN, I_CCONVW, I_CCONVB, I_CALOG, I_CDTB, I_CD, I_CNORMW, I_CWOUT,
       I_W1, I_W2, I_LN1W, I_LN1B, I_LN2W, I_LN2B };

__device__ __forceinline__ float bf2f(unsigned h) { return __uint_as_float(h << 16); }
typedef __bf16 bf16x2_t __attribute__((ext_vector_type(2)));
__device__ __forceinline__ unsigned cvt_pk_bf16(float lo, float hi) { f32x2 v = {lo, hi}; bf16x2_t b = __builtin_convertvector(v, bf16x2_t); return __builtin_bit_cast(unsigned, b); }
__device__ __forceinline__ unsigned f2bf(float f) { return cvt_pk_bf16(f, 0.f) & 0xffffu; }
__device__ __forceinline__ float siluf(float x) { return x * __builtin_amdgcn_rcpf(1.f + __expf(-x)); }
__device__ __forceinline__ float softplusf(float x) { return x > 20.f ? x : log1pf(__expf(x)); }
__device__ __forceinline__ int tok_row(int b, int L) { return L < 64 ? (MMAIN + L - 48) : (b * SEQ + L - 64); }
__device__ __forceinline__ bf16x8 mk8(u32x2 lo, u32x2 hi) { u32x4 v = {lo.x, lo.y, hi.x, hi.y}; return __builtin_bit_cast(bf16x8, v); }
__device__ __forceinline__ bf16x8 pack8(f32x4 a, f32x4 b) { u32x4 v = {cvt_pk_bf16(a[0], a[1]), cvt_pk_bf16(a[2], a[3]), cvt_pk_bf16(b[0], b[1]), cvt_pk_bf16(b[2], b[3])}; return __builtin_bit_cast(bf16x8, v); }
__device__ __forceinline__ float row16_sum(float v) {
    v += __builtin_bit_cast(float, __builtin_amdgcn_update_dpp(0, __builtin_bit_cast(int, v), 0xB1, 0xF, 0xF, true));
    v += __builtin_bit_cast(float, __builtin_amdgcn_update_dpp(0, __builtin_bit_cast(int, v), 0x4E, 0xF, 0xF, true));
    v += __builtin_bit_cast(float, __builtin_amdgcn_update_dpp(0, __builtin_bit_cast(int, v), 0x141, 0xF, 0xF, true));
    v += __builtin_bit_cast(float, __builtin_amdgcn_update_dpp(0, __builtin_bit_cast(int, v), 0x140, 0xF, 0xF, true));
    return v;
}
#define MFMA16(a, b, c) __builtin_amdgcn_mfma_f32_16x16x32_bf16((a), (b), (c), 0, 0, 0)

namespace pg8 {
constexpr int BM = 256, BK = 64, HALF = 128, HTB = HALF * BK * 2, STAGE_BYTES = 8 * HTB, NXCD = 8, WGM = 8;
__host__ __device__ __forceinline__ int lds_byte(int r, int c) { const int st = (r >> 4) * 2 + (c >> 5), rr = r & 15, cc = c & 31, ob = rr * 64 + cc * 2; return st * 1024 + (ob ^ (((ob >> 9) & 1) << 5)); }
__host__ __device__ __forceinline__ void stage_rc(int b, int& R, int& C) { const int st = b / 1024, sb = b % 1024, swz = sb ^ (((sb >> 9) & 1) << 5); R = (st >> 1) * 16 + swz / 64; C = (st & 1) * 32 + (swz % 64) / 2; }
__host__ __device__ __forceinline__ int perm32(int rho) { const int n = rho >> 4, i = rho & 15; return 8 * (i >> 2) + 4 * n + (i & 3); }
struct Unit { int pm, pn; };
struct Gemm { const bf16_t* A; const bf16_t* Bt; int M, N, K; };
struct StaticOrder {
    int nM, nN, nwg, G, c;
    __device__ void init(int M, int N, int G_, int c_) { nM = M / BM; nN = N / BM; nwg = nM * nN; G = G_; c = c_; }
    __device__ bool next(int i, Unit& u) const {
        const long L = (long)i * G + c; if (L >= nwg) return false;
        int wgid = (int)L; { const int q = nwg / NXCD, r = nwg % NXCD, xcd = wgid % NXCD, off = wgid / NXCD; wgid = (xcd < r ? xcd * (q + 1) : r * (q + 1) + (xcd - r) * q) + off; }
        const int nig = WGM * nN, gid = wgid / nig, fm = gid * WGM, gsz = (nM - fm) < WGM ? (nM - fm) : WGM;
        u.pm = fm + ((wgid % nig) % gsz); u.pn = (wgid % nig) / gsz; return true;
    }
};

template <class Epi, class XB>
__device__ __forceinline__ void gemm_phase(LAS uchar* lds, const Gemm g, const StaticOrder& S, const Epi& E, const int tid, const XB& xbar) {
    const int wid = __builtin_amdgcn_readfirstlane(tid >> 6), lane = tid & 63, wr = wid >> 2, wc = wid & 3, fr = lane & 15, fq = lane >> 4;
    const int K = g.K, nt = K / BK;
    unsigned voffA[2], voffB[2];
#pragma unroll
    for (int i = 0; i < 2; ++i) { int R, C; stage_rc(tid * 16 + i * 8192, R, C); const int Rb = (R & ~31) + perm32(R & 31);
        voffA[i] = (unsigned)(R * K + C) * 2u; voffB[i] = (unsigned)(Rb * K + C) * 2u; }
    const size_t kstep = (size_t)(BK * 2);
    const size_t hstep = (size_t)HALF * K * 2;
    const size_t tstep = 2 * hstep;
    const unsigned ldsw = (unsigned)wid * 1024u;
    const int aoff = lds_byte(wr * 64 + fr, fq * 8), boff = lds_byte(wc * 32 + fr, fq * 8);
#define PG8_SA(b, h) (((b) * 2 + (h)) * HTB)
#define PG8_SB(b, h) ((4 + (b) * 2 + (h)) * HTB)
#define PG8_STAGE(bufoff, gbase, voff) do { _Pragma("unroll") for (int _i = 0; _i < 2; ++_i) \
        __builtin_amdgcn_global_load_lds((const unsigned*)((const char*)(gbase) + (voff)[_i]), (LAS unsigned*)(lds + (bufoff) + ldsw + _i * 8192), 16, 0, 0); } while (0)
#define PG8_LDA(dst, b, h) do { _Pragma("unroll") for (int m = 0; m < 4; ++m) _Pragma("unroll") for (int k = 0; k < 2; ++k) dst[m][k] = *(const LAS bf16x8*)(lds + PG8_SA(b, h) + aoff + m * 2048 + k * 1024); } while (0)
#define PG8_LDB(dst, b, h) do { _Pragma("unroll") for (int n = 0; n < 2; ++n) _Pragma("unroll") for (int k = 0; k < 2; ++k) dst[n][k] = *(const LAS bf16x8*)(lds + PG8_SB(b, h) + boff + n * 2048 + k * 1024); } while (0)
#define PG8_MMA(ai, bj, At, Bt) do { __builtin_amdgcn_s_setprio(1); _Pragma("unroll") for (int m = 0; m < 4; ++m) _Pragma("unroll") for (int n = 0; n < 2; ++n) _Pragma("unroll") for (int k = 0; k < 2; ++k) \
        acc[ai][bj][m][n] = __builtin_amdgcn_mfma_f32_16x16x32_bf16(Bt[n][k], At[m][k], acc[ai][bj][m][n], 0, 0, 0); __builtin_amdgcn_s_setprio(0); } while (0)
#define PG8_WAIT_V(n) asm volatile("s_waitcnt vmcnt(" #n ")" ::: "memory")
#define PG8_WAIT_L(n) asm volatile("s_waitcnt lgkmcnt(" #n ")" ::: "memory")
#define PG8_BAR __builtin_amdgcn_s_barrier()
#define PG8_SCHED __builtin_amdgcn_sched_barrier(0)
    Unit cur, nxt; int ui = 0;
    if (!S.next(0, cur)) return;
    f32x4 acc[2][2][4][2];
#pragma unroll
    for (int a = 0; a < 2; ++a)
#pragma unroll
        for (int b = 0; b < 2; ++b)
#pragma unroll
            for (int m = 0; m < 4; ++m)
#pragma unroll
                for (int n = 0; n < 2; ++n) acc[a][b][m][n] = (f32x4){0.f, 0.f, 0.f, 0.f};
    bf16x8 At[4][2], B0[2][2], B1[2][2];
    const char* cA = (const char*)g.A + (size_t)cur.pm * tstep; const char* cB = (const char*)g.Bt + (size_t)cur.pn * tstep;
    PG8_STAGE(PG8_SB(0, 0), cB, voffB); PG8_STAGE(PG8_SB(0, 1), cB + hstep, voffB); PG8_STAGE(PG8_SA(0, 0), cA, voffA); PG8_STAGE(PG8_SA(0, 1), cA + hstep, voffA);
    if (wr == 1) PG8_BAR;
    PG8_WAIT_V(2); PG8_BAR;
    PG8_STAGE(PG8_SB(1, 0), cB + kstep, voffB); PG8_STAGE(PG8_SA(1, 0), cA + kstep, voffA); PG8_STAGE(PG8_SB(1, 1), cB + hstep + kstep, voffB);
    PG8_WAIT_V(6); PG8_BAR;
    for (;;) {
        const bool has_next = S.next(ui + 1, nxt);
        const char* nA = has_next ? (const char*)g.A + (size_t)nxt.pm * tstep : cA; const char* nB = has_next ? (const char*)g.Bt + (size_t)nxt.pn * tstep : cB;
        for (int t = 0; t < nt; t += 2) {
            const bool last = (t == nt - 2);
            const char* a1 = cA + (size_t)(t + 1) * kstep;
            const char* a2 = last ? nA : cA + (size_t)(t + 2) * kstep; const char* b2 = last ? nB : cB + (size_t)(t + 2) * kstep;
            const char* a3 = a2 + kstep; const char* b3 = b2 + kstep;
            PG8_LDB(B0, 0, 0); PG8_LDB(B1, 0, 1); PG8_SCHED; PG8_LDA(At, 0, 0); PG8_STAGE(PG8_SA(1, 1), a1 + hstep, voffA);
            PG8_WAIT_V(8); PG8_WAIT_L(0); PG8_BAR; PG8_MMA(0, 0, At, B0); PG8_MMA(0, 1, At, B1); PG8_BAR; PG8_SCHED;
            PG8_LDA(At, 0, 1); PG8_STAGE(PG8_SB(0, 0), b2, voffB); PG8_STAGE(PG8_SB(0, 1), b2 + hstep, voffB); PG8_STAGE(PG8_SA(0, 0), a2, voffA);
            PG8_WAIT_V(8); PG8_WAIT_L(0); PG8_BAR; PG8_MMA(1, 0, At, B0); PG8_MMA(1, 1, At, B1); PG8_BAR; PG8_SCHED;
            PG8_LDB(B0, 1, 0); PG8_LDB(B1, 1, 1); PG8_SCHED; PG8_LDA(At, 1, 0); PG8_STAGE(PG8_SA(0, 1), a2 + hstep, voffA);
            PG8_WAIT_V(8); PG8_WAIT_L(0); PG8_BAR; PG8_MMA(0, 0, At, B0); PG8_MMA(0, 1, At, B1); PG8_BAR; PG8_SCHED;
            PG8_LDA(At, 1, 1); PG8_STAGE(PG8_SB(1, 0), b3, voffB); PG8_STAGE(PG8_SB(1, 1), b3 + hstep, voffB); PG8_STAGE(PG8_SA(1, 0), a3, voffA);
            PG8_WAIT_V(8); PG8_WAIT_L(0); PG8_BAR; PG8_MMA(1, 0, At, B0); PG8_MMA(1, 1, At, B1); PG8_BAR; PG8_SCHED;
        }
        if (wr == 0) PG8_BAR;
        if constexpr (!Epi::AFTER_DRAIN) E(acc, cur, wr, wc, fr, fq);
        if (!has_next) break;
#pragma unroll
        for (int a = 0; a < 2; ++a)
#pragma unroll
            for (int b = 0; b < 2; ++b)
#pragma unroll
                for (int m = 0; m < 4; ++m)
#pragma unroll
                    for (int n = 0; n < 2; ++n) acc[a][b][m][n] = (f32x4){0.f, 0.f, 0.f, 0.f};
        cur = nxt; cA = nA; cB = nB; ++ui;
        if (wr == 1) PG8_BAR;
    }
    PG8_WAIT_V(0);
    PG8_BAR;
    if constexpr (Epi::AFTER_DRAIN) E.fused(acc, cur, wr, wc, fr, fq, lds, tid, xbar);
#undef PG8_SA
#undef PG8_SB
#undef PG8_STAGE
#undef PG8_LDA
#undef PG8_LDB
#undef PG8_MMA
#undef PG8_WAIT_V
#undef PG8_WAIT_L
#undef PG8_BAR
#undef PG8_SCHED
}
}

template <int MODE> struct Epi {
    static constexpr bool AFTER_DRAIN = false;
    bf16_t* o1; int ld1; int split; bf16_t* o2; int ld2; float* Rm; float* Rt; const float* x; const float* meta; float* side;
    __device__ __forceinline__ float* rptr(int row) const { return row < MMAIN ? Rm + (size_t)row * DM : Rt + (size_t)(row - MMAIN) * DM; }
    __device__ __forceinline__ void store4(int row, int col, f32x4 v) const {
        if (MODE == 0) {
            if (col < split) { u32x2 w = {cvt_pk_bf16(v[0], v[1]), cvt_pk_bf16(v[2], v[3])}; *(u32x2*)(o1 + (size_t)row * ld1 + col) = w; }
            else { u32x2 w = {cvt_pk_bf16(siluf(v[0]), siluf(v[1])), cvt_pk_bf16(siluf(v[2]), siluf(v[3]))}; *(u32x2*)(o2 + (size_t)row * ld2 + (col - split)) = w; }
        } else if (MODE == 1) {
            f32x4 r; for (int i = 0; i < 4; ++i) { const float t = fmaxf(v[i], 0.f); r[i] = t * t; }
            u32x2 w = {cvt_pk_bf16(r[0], r[1]), cvt_pk_bf16(r[2], r[3])}; *(u32x2*)(o1 + (size_t)row * ld1 + col) = w;
        } else if (MODE == 2) {
            const float* hp = row < MMAIN ? x + (size_t)row * DM + col : meta + (size_t)(row - MMAIN) * DM + col;
            const f32x4 h = *(const f32x4*)hp; *(f32x4*)(rptr(row) + col) = h * DN_ALPHA + v;
        } else if (MODE == 3) {
            float* rp = rptr(row) + col; const f32x4 h = *(const f32x4*)rp; *(f32x4*)rp = h * DN_ALPHA + v;
        } else {
            if (col < 32) *(f32x4*)(side + (size_t)row * 32 + col) = v;
        }
    }
    __device__ __forceinline__ void operator()(const f32x4 (&acc)[2][2][4][2], const pg8::Unit& u, int wr, int wc, int fr, int fq) const {
        const int row0 = u.pm * 256 + wr * 64 + fr, colt = u.pn * 256 + wc * 32 + 8 * fq;
        if (MODE == 0 || MODE == 1) {
            const bool sec = (MODE == 0) && (u.pn * 256 >= split);
            bf16_t* base = sec ? o2 + (colt - split) : o1 + colt; const int ld = sec ? ld2 : ld1;
#pragma unroll
            for (int ai = 0; ai < 2; ++ai)
#pragma unroll
                for (int m = 0; m < 4; ++m) {
                    bf16_t* rp = base + (size_t)(row0 + ai * 128 + m * 16) * ld;
#pragma unroll
                    for (int bj = 0; bj < 2; ++bj) {
                        f32x4 v0 = acc[ai][bj][m][0], v1 = acc[ai][bj][m][1];
                        if (MODE == 1) {
#pragma unroll
                            for (int i = 0; i < 4; ++i) { const float a = fmaxf(v0[i], 0.f), b = fmaxf(v1[i], 0.f); v0[i] = a * a; v1[i] = b * b; }
                        } else if (sec) {
#pragma unroll
                            for (int i = 0; i < 4; ++i) { v0[i] = siluf(v0[i]); v1[i] = siluf(v1[i]); }
                        }
                        u32x4 w = {cvt_pk_bf16(v0[0], v0[1]), cvt_pk_bf16(v0[2], v0[3]), cvt_pk_bf16(v1[0], v1[1]), cvt_pk_bf16(v1[2], v1[3])};
                        *(u32x4*)(rp + bj * 128) = w;
                    }
                }
        } else {
#pragma unroll
            for (int ai = 0; ai < 2; ++ai)
#pragma unroll
                for (int m = 0; m < 4; ++m) {
                    const int row = row0 + ai * 128 + m * 16;
                    float* rp = Rm + (size_t)row * DM + colt;
                    const float* hp = (MODE == 2) ? x + (size_t)row * DM + colt : rp;
#pragma unroll
                    for (int bj = 0; bj < 2; ++bj) {
                        const f32x4 h0 = *(const f32x4*)(hp + bj * 128), h1 = *(const f32x4*)(hp + bj * 128 + 4);
                        *(f32x4*)(rp + bj * 128) = h0 * DN_ALPHA + acc[ai][bj][m][0]; *(f32x4*)(rp + bj * 128 + 4) = h1 * DN_ALPHA + acc[ai][bj][m][1];
                    }
                    asm volatile("" ::: "memory");
                    __builtin_amdgcn_sched_barrier(0);
                }
        }
    }
};

template <int RT, class E>
__device__ __forceinline__ void skinny_gemm(LAS uchar* lds, const bf16_t* A, int lda, const bf16_t* Bt, int K, int row0, int nrt, int nct, const E& epi, int task0, int ntask_stride, const int tid) {
    const int wid = tid >> 6, lane = tid & 63, fr = lane & 15, fq = lane >> 4;
    LAS f32x4* red = (LAS f32x4*)lds;
    const int nrg = (nrt + RT - 1) / RT, ntasks = nrg * nct, kw = K / 8;
    for (int task = task0; task < ntasks; task += ntask_stride) {
        const int rg = task / nct, ct = task % nct;
        const bf16_t* bp0 = Bt + (size_t)(32 * ct + fr) * K + wid * kw + 8 * fq;
        const bf16_t* bp1 = bp0 + (size_t)16 * K;
        const bf16_t* ap[RT];
#pragma unroll
        for (int r = 0; r < RT; ++r) { const int rt = (RT * rg + r < nrt) ? RT * rg + r : nrt - 1; ap[r] = A + (size_t)(row0 + 16 * rt + fr) * lda + wid * kw + 8 * fq; }
        f32x4 acc[RT][2];
#pragma unroll
        for (int r = 0; r < RT; ++r) { acc[r][0] = (f32x4){0.f, 0.f, 0.f, 0.f}; acc[r][1] = (f32x4){0.f, 0.f, 0.f, 0.f}; }
#pragma unroll 2
        for (int k = 0; k < kw; k += 32) {
            const bf16x8 b0 = *(const bf16x8*)(bp0 + k), b1 = *(const bf16x8*)(bp1 + k);
#pragma unroll
            for (int r = 0; r < RT; ++r) { const bf16x8 av = *(const bf16x8*)(ap[r] + k); acc[r][0] = MFMA16(b0, av, acc[r][0]); acc[r][1] = MFMA16(b1, av, acc[r][1]); }
        }
#pragma unroll
        for (int r = 0; r < RT; ++r) { red[((wid * RT + r) * 2 + 0) * 64 + lane] = acc[r][0]; red[((wid * RT + r) * 2 + 1) * 64 + lane] = acc[r][1]; }
        __syncthreads();
        for (int o = wid; o < RT * 2; o += 8) {
            const int r = o >> 1, n = o & 1;
            if (RT * rg + r < nrt) {
                f32x4 s = {0.f, 0.f, 0.f, 0.f};
#pragma unroll
                for (int w = 0; w < 8; ++w) s += red[((w * RT + r) * 2 + n) * 64 + lane];
                epi.store4(row0 + 16 * (RT * rg + r) + fr, 32 * ct + 16 * n + 4 * fq, s);
            }
        }
        __syncthreads();
    }
}

__device__ __forceinline__ void transpose_item(const float* W, int ldw, int src0, int nblk, bf16_t* WT, int K, int dst0, LAS float* scr, int item, int lane) {
    const int kb = item / nblk, nb = item % nblk, k0 = 64 * kb, n0 = 32 * nb;
    {
        const int kq = lane >> 3, n4 = (lane & 7) * 4;
        f32x4 v[8];
#pragma unroll
        for (int i = 0; i < 8; ++i) v[i] = *(const f32x4*)(W + (size_t)(k0 + 8 * i + kq) * ldw + src0 + n0 + n4);
#pragma unroll
        for (int i = 0; i < 8; ++i) { LAS float* d = scr + (8 * i + kq) * 33 + n4; d[0] = v[i][0]; d[1] = v[i][1]; d[2] = v[i][2]; d[3] = v[i][3]; }
    }
    asm volatile("s_waitcnt lgkmcnt(0)" ::: "memory");
    const int c = lane & 7;
#pragma unroll
    for (int j = 0; j < 4; ++j) { const int n = (lane >> 3) + 8 * j; const LAS float* s = scr + (8 * c) * 33 + n;
        u32x4 o; o.x = cvt_pk_bf16(s[0 * 33], s[1 * 33]); o.y = cvt_pk_bf16(s[2 * 33], s[3 * 33]); o.z = cvt_pk_bf16(s[4 * 33], s[5 * 33]); o.w = cvt_pk_bf16(s[6 * 33], s[7 * 33]);
        *(u32x4*)(WT + (size_t)(dst0 + n0 + n) * K + k0 + 8 * c) = o; }
    asm volatile("s_waitcnt lgkmcnt(0)" ::: "memory");
}
struct TSeg { const float* W; int ldw, src0, n, K; bf16_t* WT; int dst0; };
template <int NS>
__device__ __forceinline__ void transpose_segs(LAS uchar* lds, const TSeg (&segs)[NS], const int tid) {
    const int lane = tid & 63, wave = tid >> 6;
    LAS float* scr = (LAS float*)(lds + wave * 8704);
    const int gw = blockIdx.x * 8 + wave, NGW = gridDim.x * 8;
    int base = 0, next = gw;
#pragma unroll
    for (int s = 0; s < NS; ++s) {
        const int nblk = segs[s].n / 32, items = nblk * (segs[s].K / 64);
        for (; next < base + items; next += NGW) transpose_item(segs[s].W, segs[s].ldw, segs[s].src0, nblk, segs[s].WT, segs[s].K, segs[s].dst0, scr, next - base, lane);
        base += items;
    }
}

__device__ __forceinline__ float wave_sum(float v) {
#pragma unroll
    for (int o = 1; o < 64; o <<= 1) v += __shfl_xor(v, o);
    return v;
}
__device__ __forceinline__ void ln_phase(float* Rm, float* Rt, const float* w, const float* bia, bf16_t* hb, bool final_, const int tid) {
    const int lane = tid & 63, gw = blockIdx.x * 8 + (tid >> 6), NGW = gridDim.x * 8;
    const int nrows = final_ ? MMAIN : MROWS;
    f32x4 wv[4], bv[4];
#pragma unroll
    for (int j = 0; j < 4; ++j) { wv[j] = ((const f32x4*)w)[lane + 64 * j]; bv[j] = ((const f32x4*)bia)[lane + 64 * j]; }
    for (int row = gw; row < nrows; row += NGW) {
        float* rp = row < MMAIN ? Rm + (size_t)row * DM : Rt + (size_t)(row - MMAIN) * DM;
        f32x4 v[4]; float s = 0.f;
#pragma unroll
        for (int j = 0; j < 4; ++j) { v[j] = ((const f32x4*)rp)[lane + 64 * j]; s += (v[j][0] + v[j][1]) + (v[j][2] + v[j][3]); }
        const float mean = wave_sum(s) * (1.f / DM); float s2 = 0.f;
#pragma unroll
        for (int j = 0; j < 4; ++j) { v[j] = v[j] - mean; s2 += (v[j][0] * v[j][0] + v[j][1] * v[j][1]) + (v[j][2] * v[j][2] + v[j][3] * v[j][3]); }
        const float rstd = 1.f / sqrtf(wave_sum(s2) * (1.f / DM) + 1e-5f);
#pragma unroll
        for (int j = 0; j < 4; ++j) {
            const f32x4 y = v[j] * rstd * wv[j] + bv[j];
            ((f32x4*)rp)[lane + 64 * j] = y;
            if (!final_) { u32x2 o = {cvt_pk_bf16(y[0], y[1]), cvt_pk_bf16(y[2], y[3])}; ((u32x2*)(hb + (size_t)row * DM))[lane + 64 * j] = o; }
        }
    }
}
__device__ __forceinline__ void rmsnorm_phase(bf16_t* Y, const float* nw, const int tid) {
    const int lane = tid & 63, gw = blockIdx.x * 8 + (tid >> 6), NGW = gridDim.x * 8;
    const f32x4* wp = (const f32x4*)(nw + 32 * lane);
    for (int row0 = gw; row0 < MROWS; row0 += 2 * NGW) {
        u32x4 raw[2][4];
#pragma unroll
        for (int q = 0; q < 2; ++q) {
            const int row = row0 + q * NGW;
            if (row < MROWS) {
                const u32x4* yp = (const u32x4*)(Y + (size_t)row * 2048 + 32 * lane);
#pragma unroll
                for (int j = 0; j < 4; ++j) raw[q][j] = yp[j];
            }
        }
#pragma unroll
        for (int q = 0; q < 2; ++q) {
            const int row = row0 + q * NGW;
            if (row < MROWS) {
                u32x4* yp = (u32x4*)(Y + (size_t)row * 2048 + 32 * lane);
                float f[32]; float ss = 0.f;
#pragma unroll
                for (int j = 0; j < 4; ++j)
#pragma unroll
                    for (int e = 0; e < 4; ++e) { const unsigned u = raw[q][j][e]; const float lo = bf2f(u & 0xffffu), hi = bf2f(u >> 16); f[8 * j + 2 * e] = lo; f[8 * j + 2 * e + 1] = hi; ss += lo * lo + hi * hi; }
                ss = row16_sum(ss);
                const float rstd = 1.f / sqrtf(ss * (1.f / 512.f) + 1e-6f);
#pragma unroll
                for (int j = 0; j < 4; ++j) { const f32x4 w0 = wp[2 * j], w1 = wp[2 * j + 1];
                    u32x4 o; o.x = cvt_pk_bf16(f[8 * j] * rstd * w0[0], f[8 * j + 1] * rstd * w0[1]); o.y = cvt_pk_bf16(f[8 * j + 2] * rstd * w0[2], f[8 * j + 3] * rstd * w0[3]);
                    o.z = cvt_pk_bf16(f[8 * j + 4] * rstd * w1[0], f[8 * j + 5] * rstd * w1[1]); o.w = cvt_pk_bf16(f[8 * j + 6] * rstd * w1[2], f[8 * j + 7] * rstd * w1[3]);
                    yp[j] = o; }
            }
        }
    }
}

__device__ __forceinline__ void conv8(const bf16_t* P, int ld, int b, int L, int col0, const float* cw, int cwld, int wcol0, const float* cb, float (&out)[8]) {
#pragma unroll
    for (int e = 0; e < 8; ++e) out[e] = cb ? cb[wcol0 + e] : 0.f;
#pragma unroll
    for (int j = 0; j < 4; ++j) {
        const int Lj = L - 3 + j;
        if (Lj >= 48) {
            const u32x4 raw = *(const u32x4*)(P + (size_t)tok_row(b, Lj) * ld + col0);
            const f32x4 w0 = *(const f32x4*)(cw + (size_t)j * cwld + wcol0), w1 = *(const f32x4*)(cw + (size_t)j * cwld + wcol0 + 4);
            out[0] += bf2f(raw[0] & 0xffffu) * w0[0]; out[1] += bf2f(raw[0] >> 16) * w0[1]; out[2] += bf2f(raw[1] & 0xffffu) * w0[2]; out[3] += bf2f(raw[1] >> 16) * w0[3];
            out[4] += bf2f(raw[2] & 0xffffu) * w1[0]; out[5] += bf2f(raw[2] >> 16) * w1[1]; out[6] += bf2f(raw[3] & 0xffffu) * w1[2]; out[7] += bf2f(raw[3] >> 16) * w1[3];
        }
    }
#pragma unroll
    for (int e = 0; e < 8; ++e) out[e] = siluf(out[e]);
}
__device__ __forceinline__ u32x4 pk8(const float (&v)[8]) { u32x4 o = {cvt_pk_bf16(v[0], v[1]), cvt_pk_bf16(v[2], v[3]), cvt_pk_bf16(v[4], v[5]), cvt_pk_bf16(v[6], v[7])}; return o; }

__device__ __forceinline__ int range_row0(int rr) { return rr < 512 ? (rr >> 8) * SEQ + 32 * (rr & 255) : MMAIN; }
__device__ __forceinline__ void halo_save(const bf16_t* P, int ld, int col0, int ncg, bf16_t* HS, const int tid) {
    const int total = 513 * 3 * ncg;
    for (int it = blockIdx.x * NTHREADS + tid; it < total; it += gridDim.x * NTHREADS) {
        const int cgp = it % ncg, k = (it / ncg) % 3, rr = it / (3 * ncg);
        u32x4 v = {0u, 0u, 0u, 0u};
        if (rr < 512) { const int row = ((rr & 255) == 0) ? (MMAIN + 13 + k) : (range_row0(rr) - 3 + k); v = *(const u32x4*)(P + (size_t)row * ld + col0 + 8 * cgp); }
        *(u32x4*)(HS + ((size_t)(rr * 3 + k) * ncg + cgp) * 8) = v;
    }
}
__device__ __forceinline__ void unpack8(const u32x4 raw, float (&o)[8]) {
#pragma unroll
    for (int e = 0; e < 4; ++e) { o[2 * e] = bf2f(raw[e] & 0xffffu); o[2 * e + 1] = bf2f(raw[e] >> 16); }
}
template <int KIND>
__device__ __forceinline__ void conv_inplace(bf16_t* P, int ld, int col0, int ncg, const bf16_t* HS, const Params& p, const int tid) {
    const int total = 513 * ncg;
    for (int it = blockIdx.x * NTHREADS + tid; it < total; it += gridDim.x * NTHREADS) {
        const int cgp = it % ncg, rr = it / ncg;
        const float* cw; int cwld, wc; const float* cb = nullptr; bool norm = false; float scale = 1.f;
        if (KIND == 0) {
            if (cgp < 64) { cw = p.in[I_CONVQ]; cwld = 512; wc = 8 * cgp; norm = true; scale = 0.08838834764831845f; }
            else if (cgp < 128) { cw = p.in[I_CONVK]; cwld = 512; wc = 8 * (cgp - 64); norm = true; }
            else { cw = p.in[I_CONVV]; cwld = 1024; wc = 8 * (cgp - 128); }
        } else { cw = p.in[I_CCONVW]; cwld = 3072; wc = 8 * cgp; cb = p.in[I_CCONVB]; }
        float c0[8], c1[8], c2[8], c3[8], bs[8];
#pragma unroll
        for (int e = 0; e < 8; ++e) { c0[e] = cw[wc + e]; c1[e] = cw[cwld + wc + e]; c2[e] = cw[2 * cwld + wc + e]; c3[e] = cw[3 * cwld + wc + e]; bs[e] = cb ? cb[wc + e] : 0.f; }
        float w0[8], w1[8], w2[8];
        unpack8(*(const u32x4*)(HS + ((size_t)(rr * 3 + 0) * ncg + cgp) * 8), w0);
        unpack8(*(const u32x4*)(HS + ((size_t)(rr * 3 + 1) * ncg + cgp) * 8), w1);
        unpack8(*(const u32x4*)(HS + ((size_t)(rr * 3 + 2) * ncg + cgp) * 8), w2);
        bf16_t* rp = P + (size_t)range_row0(rr) * ld + col0 + 8 * cgp;
        const int len = rr < 512 ? 32 : 16;
#pragma unroll 8
        for (int r = 0; r < len; ++r) {
            float cur[8], o[8];
            unpack8(*(const u32x4*)(rp + (size_t)r * ld), cur);
            float ss = 0.f;
#pragma unroll
            for (int e = 0; e < 8; ++e) { const float a = bs[e] + w0[e] * c0[e] + w1[e] * c1[e] + w2[e] * c2[e] + cur[e] * c3[e]; o[e] = siluf(a); ss += o[e] * o[e]; w0[e] = w1[e]; w1[e] = w2[e]; w2[e] = cur[e]; }
            if (KIND == 0) {
                ss = row16_sum(ss);
                const float sc = norm ? scale / sqrtf(ss + 1e-6f) : 1.f;
#pragma unroll
                for (int e = 0; e < 8; ++e) o[e] *= sc;
            }
            u32x4 ov = {cvt_pk_bf16(o[0], o[1]), cvt_pk_bf16(o[2], o[3]), cvt_pk_bf16(o[4], o[5]), cvt_pk_bf16(o[6], o[7])};
            *(u32x4*)(rp + (size_t)r * ld) = ov;
        }
    }
}
__device__ __forceinline__ void rope_inplace(bf16_t* P, const uchar* ws, const int tid) {
    const int lane = tid & 63, gw = blockIdx.x * 8 + (tid >> 6), NGW = gridDim.x * 8;
    const int isk = lane >> 5, cgp = lane & 7, col = (lane >> 3) * 128 + 8 * cgp;
    const float sc = isk ? 1.f : 0.08838834764831845f;
    for (int row0 = gw; row0 < MROWS; row0 += 2 * NGW) {
        u32x4 r1[2], r2[2]; f32x2 csv[2][8]; bool ok[2];
#pragma unroll
        for (int q = 0; q < 2; ++q) {
            const int row = row0 + q * NGW; ok[q] = row < MROWS;
            if (ok[q]) {
                const int L = row < MMAIN ? 64 + (row & (SEQ - 1)) : 48 + (row - MMAIN);
                const bf16_t* rp = P + (size_t)row * 4096 + col;
                r1[q] = *(const u32x4*)rp; r2[q] = *(const u32x4*)(rp + 64);
                const f32x2* cs = (const f32x2*)(ws + OFF_CS) + (size_t)L * 64 + 8 * cgp;
#pragma unroll
                for (int e = 0; e < 8; ++e) csv[q][e] = cs[e];
            }
        }
#pragma unroll
        for (int q = 0; q < 2; ++q) {
            if (ok[q]) {
                bf16_t* rp = P + (size_t)(row0 + q * NGW) * 4096 + col;
                float x1[8], x2[8], o1[8], o2[8];
                unpack8(r1[q], x1); unpack8(r2[q], x2);
#pragma unroll
                for (int e = 0; e < 8; ++e) { const f32x2 c = csv[q][e]; o1[e] = (x1[e] * c[0] - x2[e] * c[1]) * sc; o2[e] = (x1[e] * c[1] + x2[e] * c[0]) * sc; }
                u32x4 a = {cvt_pk_bf16(o1[0], o1[1]), cvt_pk_bf16(o1[2], o1[3]), cvt_pk_bf16(o1[4], o1[5]), cvt_pk_bf16(o1[6], o1[7])};
                u32x4 bq = {cvt_pk_bf16(o2[0], o2[1]), cvt_pk_bf16(o2[2], o2[3]), cvt_pk_bf16(o2[4], o2[5]), cvt_pk_bf16(o2[6], o2[7])};
                *(u32x4*)rp = a; *(u32x4*)(rp + 64) = bq;
            }
        }
    }
}

constexpr int L_Q = 0, L_K = 17408, L_KT = 34816, L_V = 53248, L_ATT = 87040, L_TINV = 104448, L_FL = 113664;
constexpr int QS = 136  , KTS = 72, VS = 264, ATS = 68, TIS = 72;
constexpr int F_GC = 0, F_EG = 256, F_DL = 512, F_DT = 768, F_BETA = 1024, F_EL = 1088, F_PQ = 1152, F_PK = 2176, F_RED = 3200, F_RST = 4224;

template <int NC>
__device__ __forceinline__ void copy_tile(LAS uchar* lds, int ldsoff, int STR, const bf16_t* P, int ld, int col0, int b, int c, const int tid) {
    constexpr int NCG = NC / 8, RPI = 512 / NCG, NIT = 64 / RPI;
#pragma unroll
    for (int i = 0; i < NIT; ++i) {
        const int t = tid / NCG + RPI * i, cgp = tid % NCG, L = 64 * c + t;
        u32x4 raw = {0u, 0u, 0u, 0u};
        if (L >= 48) raw = *(const u32x4*)(P + (size_t)tok_row(b, L) * ld + col0 + 8 * cgp);
        *(LAS u32x4*)(lds + ldsoff + (t * STR + 8 * cgp) * 2) = raw;
    }
}
template <int NC>
__device__ __forceinline__ void tile_load(u32x4 (&r)[512 / (NC / 8) == 32 ? 2 : 4], const bf16_t* P, int ld, int col0, int b, int c, const int tid) {
    constexpr int NCG = NC / 8, RPI = 512 / NCG, NIT = 64 / RPI;
#pragma unroll
    for (int i = 0; i < NIT; ++i) {
        const int t = tid / NCG + RPI * i, cgp = tid % NCG, L = 64 * c + t;
        r[i] = (u32x4){0u, 0u, 0u, 0u};
        if (L >= 48) r[i] = *(const u32x4*)(P + (size_t)tok_row(b, L) * ld + col0 + 8 * cgp);
    }
}
template <int NC>
__device__ __forceinline__ void tile_store(LAS uchar* lds, int ldsoff, int STR, const u32x4 (&r)[512 / (NC / 8) == 32 ? 2 : 4], const int tid) {
    constexpr int NCG = NC / 8, RPI = 512 / NCG, NIT = 64 / RPI;
#pragma unroll
    for (int i = 0; i < NIT; ++i) { const int t = tid / NCG + RPI * i, cgp = tid % NCG; *(LAS u32x4*)(lds + ldsoff + (t * STR + 8 * cgp) * 2) = r[i]; }
}
__device__ __forceinline__ void make_kT(LAS uchar* lds, const int tid) {
#pragma unroll
    for (int i = 0; i < 2; ++i) {
        const int item = tid + 512 * i, t = item & 63, cgp = item >> 6;
        const u32x4 v = *(const LAS u32x4*)(lds + L_K + (t * QS + 8 * cgp) * 2);
#pragma unroll
        for (int e = 0; e < 4; ++e) {
            *(LAS bf16_t*)(lds + L_KT + ((8 * cgp + 2 * e) * KTS + t) * 2) = (bf16_t)(v[e] & 0xffffu);
            *(LAS bf16_t*)(lds + L_KT + ((8 * cgp + 2 * e + 1) * KTS + t) * 2) = (bf16_t)(v[e] >> 16);
        }
    }
}
__device__ __forceinline__ void gdn_load_gates(LAS uchar* lds, const Params& p, uchar* ws, int b, int h, int c, const int tid) {
    LAS float* FL = (LAS float*)(lds + L_FL);
    if (tid < 64) {
        const int t = tid, L = 64 * c + t; float beta = 0.f, g = 0.f;
        if (L >= 48) {
            const float* sp = (const float*)(ws + OFF_SIDE) + (size_t)tok_row(b, L) * 32;
            beta = 1.f / (1.f + __expf(-sp[h]));
            g = -__expf(p.in[I_ABALOG][h]) * softplusf(sp[4 + h] + p.in[I_ABDTB][h]);
        }
        float v = g;
#pragma unroll
        for (int o = 1; o < 64; o <<= 1) { const float n = __shfl_up(v, o); if (t >= o) v += n; }
        const float gl = __shfl(v, 63);
        FL[F_BETA + t] = beta; FL[F_GC + t] = v; FL[F_EG + t] = __expf(v); FL[F_DL + t] = __expf(gl - v);
        if (t == 63) FL[F_EL] = __expf(gl);
    }
}

__device__ __forceinline__ void tinv_phase(LAS uchar* lds, const Params& p, uchar* ws, const int tid) {
    const int wid = tid >> 6, lane = tid & 63, fr = lane & 15, fq = lane >> 4;
    const bf16_t* P = (const bf16_t*)(ws + OFF_P);
    LAS float* FL = (LAS float*)(lds + L_FL);
    LAS float* AL = (LAS float*)(lds + L_ATT);
    for (int task = blockIdx.x; task < 2 * NCHUNK * 4; task += gridDim.x) {
        const int h = task & 3, c = (task >> 2) % NCHUNK, b = (task >> 2) / NCHUNK;
        __syncthreads();
        gdn_load_gates(lds, p, ws, b, h, c, tid);
        copy_tile<128>(lds, L_K, QS, P, 4096, 2560 + h * 128, b, c, tid);
        __syncthreads();
        {
            const int tt = wid >> 1, st0 = (wid & 1) * 2;
            f32x4 at[2] = {{0.f, 0.f, 0.f, 0.f}, {0.f, 0.f, 0.f, 0.f}};
#pragma unroll
            for (int ks = 0; ks < 4; ++ks) {
                const bf16x8 a = *(const LAS bf16x8*)(lds + L_K + ((16 * tt + fr) * QS + 32 * ks + 8 * fq) * 2);
#pragma unroll
                for (int u = 0; u < 2; ++u) { const bf16x8 bb = *(const LAS bf16x8*)(lds + L_K + ((16 * (st0 + u) + fr) * QS + 32 * ks + 8 * fq) * 2); at[u] = MFMA16(a, bb, at[u]); }
            }
#pragma unroll
            for (int u = 0; u < 2; ++u)
#pragma unroll
                for (int j = 0; j < 4; ++j) {
                    const int t = 16 * tt + 4 * fq + j, s = 16 * (st0 + u) + fr;
                    const float v = (s < t) ? FL[F_BETA + t] * at[u][j] * __expf(FL[F_GC + t] - FL[F_GC + s]) : 0.f;
                    AL[t * ATS + s] = v;
                }
        }
        __syncthreads();
        if (wid == 0) {
            int alb0 = L_ATT; asm volatile("" : "+v"(alb0));
            float x[64];
#pragma unroll
            for (int t = 0; t < 64; ++t) x[t] = 0.f;
#pragma unroll
            for (int t = 0; t < 64; ++t) {
                float a0 = (t == lane) ? 1.f : 0.f, a1 = 0.f, a2 = 0.f, a3 = 0.f;
#pragma unroll
                for (int s4 = 0; s4 * 4 < t; ++s4) {
                    const f32x4 a = *(const LAS f32x4*)(lds + alb0 + (t * ATS + 4 * s4) * 4);
                    a0 -= a[0] * x[4 * s4]; a1 -= a[1] * x[4 * s4 + 1]; a2 -= a[2] * x[4 * s4 + 2]; a3 -= a[3] * x[4 * s4 + 3];
                }
                x[t] = (a0 + a1) + (a2 + a3);
            }
            bf16_t* tp = (bf16_t*)(ws + OFF_TINV) + (size_t)task * 4096;
#pragma unroll
            for (int t = 0; t < 64; ++t) tp[t * 64 + lane] = (bf16_t)f2bf(x[t]);
        }
    }
}

#define LB(name, expr) int name = (expr); asm volatile("" : "+v"(name))
template <int MODE, int PASS, int NT, bool PF_Q = true, bool PF_K = true, bool PF_V = true>
__device__ __forceinline__ void scan_unit(LAS uchar* lds, const Params& p, uchar* ws, int b, int hd, int c0, int c1, const float* Sin, float* Sout, float* Gout, const int tid, const int cfull = 0) {
    constexpr bool GDN = (MODE == 1 || MODE == 3);
    constexpr int NCOL = 128 * NT;
    const int wid = __builtin_amdgcn_readfirstlane(tid >> 6), lane = tid & 63, fr = lane & 15, fq = lane >> 4;
    const bf16_t* P = (const bf16_t*)(ws + OFF_P);
    bf16_t* Y = (bf16_t*)(ws + OFF_Y);
    LAS float* FL = (LAS float*)(lds + L_FL);
    constexpr int LDP = (MODE == 2) ? 3072 : 4096;
    const int qc = MODE == 0 ? hd * 128 : (GDN ? 2048 + hd * 128 : 2560 + (hd >> 1) * 128);
    const int kc = MODE == 0 ? 512 + hd * 128 : (GDN ? 2560 + hd * 128 : 2048 + (hd >> 1) * 128);
    const int vc = MODE == 0 ? 1024 + hd * 256 : (GDN ? 3072 + hd * 256 : hd * 256);
    const int yc = GDN ? 1024 + hd * 256 : hd * 256;
    const int hl = (MODE == 2) ? (wid >> 1) : 0;
    const int dvw = 16 * NT * wid;
    const float lg = (MODE == 0) ? log1pf(-exp2f(-5.f - (float)hd)) : 0.f;
    float Gacc = 0.f;
    f32x4 S[8][NT];
#pragma unroll
    for (int m = 0; m < 8; ++m)
#pragma unroll
        for (int n = 0; n < NT; ++n) {
            if (MODE == 3) {
#pragma unroll
                for (int j = 0; j < 4; ++j) S[m][n][j] = (16 * m + 4 * fq + j == dvw + 16 * n + fr) ? 1.f : 0.f;
            } else if (Sin) {
#pragma unroll
                for (int j = 0; j < 4; ++j) S[m][n][j] = Sin[(size_t)(16 * m + 4 * fq + j) * NCOL + dvw + 16 * n + fr];
            } else S[m][n] = (f32x4){0.f, 0.f, 0.f, 0.f};
        }

    constexpr bool PFQ = (PASS == 0) && PF_Q, PFK = PF_K, PFV = (MODE != 3) && PF_V;
    u32x4 pq[2], pk[2], pv[4];
    {
        int tl0 = tid; asm volatile("" : "+v"(tl0));
        if (PFQ) tile_load<128>(pq, P, LDP, qc, b, c0, tl0);
        if (PFK) tile_load<128>(pk, P, LDP, kc, b, c0, tl0);
        if (PFV && PASS == 1) tile_load<256>(pv, P, LDP, vc, b, c0, tl0);
    }
    for (int c = c0; c < c1; ++c) {
        __syncthreads();
        int tl = tid; asm volatile("" : "+v"(tl));
        if (PASS == 0) { if (PFQ) tile_store<128>(lds, L_Q, QS, pq, tl); else copy_tile<128>(lds, L_Q, QS, P, LDP, qc, b, c, tl); }
        if (PFK) tile_store<128>(lds, L_K, QS, pk, tl); else copy_tile<128>(lds, L_K, QS, P, LDP, kc, b, c, tl);
        if (MODE != 3) {
            if (PASS == 0 && PFV) { if (c == c0) copy_tile<256>(lds, L_V, VS, P, LDP, vc, b, c, tl); }
            else if (PFV) tile_store<256>(lds, L_V, VS, pv, tl); else copy_tile<256>(lds, L_V, VS, P, LDP, vc, b, c, tl);
        }
        if (PASS == 1 && c + 1 < c1) {
            if (PFQ) tile_load<128>(pq, P, LDP, qc, b, c + 1, tl);
            if (PFK) tile_load<128>(pk, P, LDP, kc, b, c + 1, tl);
            if (PFV) tile_load<256>(pv, P, LDP, vc, b, c + 1, tl);
        }
        if (MODE == 0) {
            if (tl < 64) { const float v = lg * (float)(tl + 1); FL[F_GC + tl] = v; FL[F_EG + tl] = __expf(v); FL[F_DL + tl] = __expf(lg * 64.f - v); if (tl == 63) FL[F_EL] = __expf(lg * 64.f); }
        } else if (GDN) {
            gdn_load_gates(lds, p, ws, b, hd, c, tl);
            {
                const int t = tl >> 3, sg = tl & 7;
                const bf16_t* tp = (const bf16_t*)(ws + OFF_TINV) + (size_t)(((b * NCHUNK + c) << 2) + hd) * 4096;
                *(LAS u32x4*)(lds + L_TINV + (t * TIS + 8 * sg) * 2) = *(const u32x4*)(tp + t * 64 + 8 * sg);
            }
        } else {
            if (tl < 256) {
                const int t = tl & 63, hq = tl >> 6, head = hd * 4 + hq, L = 64 * c + t; float dt = 0.f, g = 0.f;
                if (L >= 48) {
                    const float* sp = (const float*)(ws + OFF_SIDE) + (size_t)tok_row(b, L) * 32;
                    dt = softplusf(sp[head] + p.in[I_CDTB][head]); g = -__expf(p.in[I_CALOG][head]) * dt;
                }
                float v = g;
#pragma unroll
                for (int o = 1; o < 64; o <<= 1) { const float n = __shfl_up(v, o); if (t >= o) v += n; }
                const float gl = __shfl(v, 63);
                FL[F_DT + hq * 64 + t] = dt; FL[F_GC + hq * 64 + t] = v; FL[F_EG + hq * 64 + t] = __expf(v); FL[F_DL + hq * 64 + t] = __expf(gl - v);
                if (t == 63) { FL[F_EL + hq] = __expf(gl); FL[F_EL + 4 + hq] = gl; }
            }
        }
        __syncthreads();
        make_kT(lds, tl);
        const bool full = (PASS == 0) && (c >= cfull);
        if (!full) __syncthreads();
        if (MODE == 2 && PASS == 1) Gacc += FL[F_EL + 4 + hl];
        if (PASS == 0 && full) {
            LB(qnb, L_Q + ((16 * (wid >> 1) + fr) * QS + 8 * fq) * 2); LB(knb, L_K + ((32 * (wid & 1) + fr) * QS + 8 * fq) * 2);
            LB(awb, L_ATT + ((16 * (wid >> 1) + 4 * fq) * ATS + 32 * (wid & 1) + fr) * 4);
            f32x4 at[2] = {{0.f, 0.f, 0.f, 0.f}, {0.f, 0.f, 0.f, 0.f}};
#pragma unroll
            for (int ks = 0; ks < 4; ++ks) {
                const bf16x8 a = *(const LAS bf16x8*)(lds + qnb + 64 * ks);
#pragma unroll
                for (int u = 0; u < 2; ++u) { const bf16x8 bb = *(const LAS bf16x8*)(lds + knb + u * (16 * QS * 2) + 64 * ks); at[u] = MFMA16(a, bb, at[u]); }
            }
#pragma unroll
            for (int u = 0; u < 2; ++u)
#pragma unroll
                for (int j = 0; j < 4; ++j) *(LAS float*)(lds + awb + (j * ATS + 16 * u) * 4) = at[u][j];
        }
        __builtin_amdgcn_sched_barrier(0);
        f32x4 Vn[4][NT];
        if (GDN) {
            LB(kpb, L_K + (fr * QS + 4 * fq) * 2); LB(flq, L_FL + (hl * 64 + 4 * fq) * 4); LB(vb, L_V + ((4 * fq) * VS + dvw + fr) * 2); LB(tib, L_TINV + (fr * TIS + 4 * fq) * 2);
            f32x4 R_[4][NT];
#pragma unroll
            for (int st = 0; st < 4; ++st)
#pragma unroll
                for (int n = 0; n < NT; ++n) R_[st][n] = (f32x4){0.f, 0.f, 0.f, 0.f};
#pragma unroll
            for (int ks = 0; ks < 4; ++ks) {
                bf16x8 bfr[NT];
#pragma unroll
                for (int n = 0; n < NT; ++n) bfr[n] = pack8(S[2 * ks][n], S[2 * ks + 1][n]);
#pragma unroll
                for (int st = 0; st < 4; ++st) {
                    const LAS uchar* ap = lds + kpb + (16 * st * QS + 32 * ks) * 2;
                    const bf16x8 a = mk8(*(const LAS u32x2*)ap, *(const LAS u32x2*)(ap + 32));
#pragma unroll
                    for (int n = 0; n < NT; ++n) R_[st][n] = MFMA16(a, bfr[n], R_[st][n]);
                }
            }
#pragma unroll
            for (int st = 0; st < 4; ++st) {
                const f32x4 be = *(const LAS f32x4*)(lds + flq + (F_BETA + 16 * st) * 4), eg = *(const LAS f32x4*)(lds + flq + (F_EG + 16 * st) * 4);
#pragma unroll
                for (int n = 0; n < NT; ++n)
#pragma unroll
                    for (int j = 0; j < 4; ++j) {
                        float v = 0.f;
                        if (MODE == 1) v = bf2f(*(const LAS bf16_t*)(lds + vb + ((16 * st + j) * VS + 16 * n) * 2));
                        R_[st][n][j] = be[j] * (v - eg[j] * R_[st][n][j]);
                    }
            }
#pragma unroll
            for (int tt = 0; tt < 4; ++tt)
#pragma unroll
                for (int n = 0; n < NT; ++n) Vn[tt][n] = (f32x4){0.f, 0.f, 0.f, 0.f};
#pragma unroll
            for (int ks = 0; ks < 2; ++ks) {
                bf16x8 bfr[NT];
#pragma unroll
                for (int n = 0; n < NT; ++n) bfr[n] = pack8(R_[2 * ks][n], R_[2 * ks + 1][n]);
#pragma unroll
                for (int tt = 0; tt < 4; ++tt) {
                    const LAS uchar* ap = lds + tib + (16 * tt * TIS + 32 * ks) * 2;
                    const bf16x8 a = mk8(*(const LAS u32x2*)ap, *(const LAS u32x2*)(ap + 32));
#pragma unroll
                    for (int n = 0; n < NT; ++n) Vn[tt][n] = MFMA16(a, bfr[n], Vn[tt][n]);
                }
            }
        } else {
            LB(flq, L_FL + (hl * 64 + 4 * fq) * 4); LB(vb, L_V + ((4 * fq) * VS + dvw + fr) * 2);
#pragma unroll
            for (int st = 0; st < 4; ++st) {
                f32x4 dtv = {1.f, 1.f, 1.f, 1.f};
                if (MODE == 2) dtv = *(const LAS f32x4*)(lds + flq + (F_DT + 16 * st) * 4);
#pragma unroll
                for (int n = 0; n < NT; ++n)
#pragma unroll
                    for (int j = 0; j < 4; ++j)
                        Vn[st][n][j] = bf2f(*(const LAS bf16_t*)(lds + vb + ((16 * st + j) * VS + 16 * n) * 2)) * dtv[j];
            }
        }
        __builtin_amdgcn_sched_barrier(0);
        f32x4 O[4][NT];
        if (PASS == 0 && full) {
            {
                LB(qpb, L_Q + (fr * QS + 4 * fq) * 2); LB(flq, L_FL + (hl * 64 + 4 * fq) * 4);
#pragma unroll
                for (int tt = 0; tt < 4; ++tt)
#pragma unroll
                    for (int n = 0; n < NT; ++n) O[tt][n] = (f32x4){0.f, 0.f, 0.f, 0.f};
#pragma unroll
                for (int ks = 0; ks < 4; ++ks) {
                    bf16x8 bfr[NT];
#pragma unroll
                    for (int n = 0; n < NT; ++n) bfr[n] = pack8(S[2 * ks][n], S[2 * ks + 1][n]);
#pragma unroll
                    for (int tt = 0; tt < 4; ++tt) {
                        const LAS uchar* ap = lds + qpb + (16 * tt * QS + 32 * ks) * 2;
                        const bf16x8 a = mk8(*(const LAS u32x2*)ap, *(const LAS u32x2*)(ap + 32));
#pragma unroll
                        for (int n = 0; n < NT; ++n) O[tt][n] = MFMA16(a, bfr[n], O[tt][n]);
                    }
                }
#pragma unroll
                for (int tt = 0; tt < 4; ++tt) {
                    const f32x4 eg = *(const LAS f32x4*)(lds + flq + (F_EG + 16 * tt) * 4);
#pragma unroll
                    for (int n = 0; n < NT; ++n) O[tt][n] = O[tt][n] * eg;
                }
            }
            __syncthreads();
            u32x4 gate[4];
            const bool wr_ok = !(c == 0 && b == 1);
            const int rowbase = (c == 0) ? (MMAIN - 48) : (b * SEQ + (c - 1) * 64);
#pragma unroll
            for (int i = 0; i < 4; ++i) {
                const int t = (tid >> 5) + 16 * i;
                gate[i] = (u32x4){0u, 0u, 0u, 0u};
                if (wr_ok && (c > 0 || t >= 48)) gate[i] = *(const u32x4*)(Y + (size_t)(rowbase + t) * 2048 + yc + 8 * (tid & 31));
            }
            if (PFV && c + 1 < c1) { int tl3 = tid; asm volatile("" : "+v"(tl3)); tile_load<256>(pv, P, LDP, vc, b, c + 1, tl3); }
            {
                LB(alb, L_ATT + (fr * ATS + 4 * fq) * 4); LB(flq, L_FL + (hl * 64 + 4 * fq) * 4); LB(flr, L_FL + (hl * 64 + fr) * 4);
#pragma unroll
                for (int ks = 0; ks < 2; ++ks) {
                    bf16x8 bfr[NT];
#pragma unroll
                    for (int n = 0; n < NT; ++n) bfr[n] = pack8(Vn[2 * ks][n], Vn[2 * ks + 1][n]);
                    const int s_lo = 32 * ks + 4 * fq, s_hi = s_lo + 16;
                    const f32x4 gs_lo = *(const LAS f32x4*)(lds + flq + (F_GC + 32 * ks) * 4), gs_hi = *(const LAS f32x4*)(lds + flq + (F_GC + 32 * ks + 16) * 4);
#pragma unroll
                    for (int tt = 0; tt < 4; ++tt) {
                        const int t = 16 * tt + fr; const float gt = *(const LAS float*)(lds + flr + (F_GC + 16 * tt) * 4);
                        f32x4 a_lo = *(const LAS f32x4*)(lds + alb + (16 * tt * ATS + 32 * ks) * 4), a_hi = *(const LAS f32x4*)(lds + alb + (16 * tt * ATS + 32 * ks + 16) * 4);
#pragma unroll
                        for (int j = 0; j < 4; ++j) {
                            a_lo[j] = (s_lo + j <= t) ? a_lo[j] * __expf(gt - gs_lo[j]) : 0.f;
                            a_hi[j] = (s_hi + j <= t) ? a_hi[j] * __expf(gt - gs_hi[j]) : 0.f;
                        }
                        const bf16x8 a = pack8(a_lo, a_hi);
#pragma unroll
                        for (int n = 0; n < NT; ++n) O[tt][n] = MFMA16(a, bfr[n], O[tt][n]);
                    }
                }
            }
#pragma unroll
            for (int i = 0; i < 4; ++i) *(LAS u32x4*)(lds + (((tid >> 5) + 16 * i) * VS + 8 * (tid & 31)) * 2) = gate[i];
        }
        __builtin_amdgcn_sched_barrier(0);
        {
            LB(ktb, L_KT + (fr * KTS + 4 * fq) * 2); LB(flq, L_FL + (hl * 64 + 4 * fq) * 4);
            const float el = FL[F_EL + hl];
#pragma unroll
            for (int m = 0; m < 8; ++m)
#pragma unroll
                for (int n = 0; n < NT; ++n) S[m][n] = S[m][n] * el;
#pragma unroll
            for (int ks = 0; ks < 2; ++ks) {
                const f32x4 d0 = *(const LAS f32x4*)(lds + flq + (F_DL + 32 * ks) * 4), d1 = *(const LAS f32x4*)(lds + flq + (F_DL + 32 * ks + 16) * 4);
                bf16x8 bfr[NT];
#pragma unroll
                for (int n = 0; n < NT; ++n) bfr[n] = pack8(Vn[2 * ks][n] * d0, Vn[2 * ks + 1][n] * d1);
#pragma unroll
                for (int m = 0; m < 8; ++m) {
                    const LAS uchar* ap = lds + ktb + (16 * m * KTS + 32 * ks) * 2;
                    const bf16x8 a = mk8(*(const LAS u32x2*)ap, *(const LAS u32x2*)(ap + 32));
#pragma unroll
                    for (int n = 0; n < NT; ++n) S[m][n] = MFMA16(a, bfr[n], S[m][n]);
                }
            }
        }
        __builtin_amdgcn_sched_barrier(0);
        if (PASS == 0 && c + 1 < c1) {
            int tl2 = tid; asm volatile("" : "+v"(tl2));
            if (PFQ) tile_load<128>(pq, P, LDP, qc, b, c + 1, tl2);
            if (PFK) tile_load<128>(pk, P, LDP, kc, b, c + 1, tl2);
        }
        if (PASS == 0 && full) {
            LB(rdb, L_FL + (F_RED + (4 * fq * 8 + wid) * 2) * 4); LB(rsb, L_FL + (F_RST + 4 * fq * 2) * 4); LB(vb2, L_V + ((4 * fq) * VS + dvw + fr) * 2);
            LB(stb, ((4 * fq) * VS + dvw + fr) * 2);
            if (MODE != 2) {
#pragma unroll
                for (int tt = 0; tt < 4; ++tt)
#pragma unroll
                    for (int j = 0; j < 4; ++j) {
                        float s1 = 0.f, s2 = 0.f;
#pragma unroll
                        for (int n = 0; n < NT; ++n) { s1 += O[tt][n][j]; s2 += O[tt][n][j] * O[tt][n][j]; }
                        s1 = row16_sum(s1); s2 = row16_sum(s2);
                        if (fr == 0) *(LAS f32x2*)(lds + rdb + ((16 * tt + j) * 8) * 8) = (f32x2){s1, s2};
                    }
                __syncthreads();
                if (tid < 64) {
                    float s1 = 0.f, s2 = 0.f;
#pragma unroll
                    for (int w = 0; w < 8; ++w) { s1 += FL[F_RED + (tid * 8 + w) * 2]; s2 += FL[F_RED + (tid * 8 + w) * 2 + 1]; }
                    float mean, rstd;
                    if (MODE == 0) { mean = s1 * (1.f / 256.f); const float var = fmaxf(s2 * (1.f / 256.f) - mean * mean, 0.f); rstd = 1.f / sqrtf(var + 1e-5f); }
                    else { mean = 0.f; rstd = 1.f / sqrtf(s2 * (1.f / 256.f) + 1e-6f); }
                    FL[F_RST + 2 * tid] = mean; FL[F_RST + 2 * tid + 1] = rstd;
                }
            }
            if (MODE == 2) {
                const float dsk = p.in[I_CD][hd * 4 + hl];
#pragma unroll
                for (int n = 0; n < NT; ++n)
#pragma unroll
                    for (int tt = 0; tt < 4; ++tt)
#pragma unroll
                        for (int j = 0; j < 4; ++j) O[tt][n][j] += bf2f(*(const LAS bf16_t*)(lds + vb2 + ((16 * tt + j) * VS + 16 * n) * 2)) * dsk;
            }
            __syncthreads();
            if (PFV && c + 1 < c1) { int tl4 = tid; asm volatile("" : "+v"(tl4)); tile_store<256>(lds, L_V, VS, pv, tl4); }
            {
                const float* nw = (MODE == 0) ? p.in[I_RETGN] + hd * 256 : p.in[I_GDNNW];
#pragma unroll
                for (int n = 0; n < NT; ++n) {
                    float wgt = 1.f;
                    if (MODE == 0 || MODE == 1) wgt = nw[dvw + 16 * n + fr];
                    if (MODE == 2) wgt = p.in[I_CD][hd * 4 + hl];
#pragma unroll
                    for (int tt = 0; tt < 4; ++tt) {
#pragma unroll
                        for (int j = 0; j < 4; ++j) {
                            float val;
                            if (MODE == 2) val = O[tt][n][j];
                            else { const f32x2 ms = *(const LAS f32x2*)(lds + rsb + (16 * tt + j) * 8); val = (O[tt][n][j] - ms[0]) * ms[1] * wgt; }
                            LAS bf16_t* sp = (LAS bf16_t*)(lds + stb + ((16 * tt + j) * VS + 16 * n) * 2);
                            *sp = (bf16_t)f2bf(val * bf2f(*sp));
                        }
                    }
                }
            }
            __syncthreads();
            if (!(c == 0 && b == 1)) {
                const int rowbase = (c == 0) ? (MMAIN - 48) : (b * SEQ + (c - 1) * 64);
#pragma unroll
                for (int i = 0; i < 4; ++i) {
                    const int t = (tid >> 5) + 16 * i;
                    if (c > 0 || t >= 48) *(u32x4*)(Y + (size_t)(rowbase + t) * 2048 + yc + 8 * (tid & 31)) = *(const LAS u32x4*)(lds + (t * VS + 8 * (tid & 31)) * 2);
                }
            }
        }
    }
    if (Sout) {
#pragma unroll
        for (int m = 0; m < 8; ++m)
#pragma unroll
            for (int n = 0; n < NT; ++n)
#pragma unroll
                for (int j = 0; j < 4; ++j) Sout[(size_t)(16 * m + 4 * fq + j) * NCOL + dvw + 16 * n + fr] = S[m][n][j];
    }
    if (MODE == 2 && PASS == 1 && Gout) { if (lane == 0 && (wid & 1) == 0) Gout[hl] = Gacc; }
}

constexpr int SEG0 = 12, NSEG0 = 11;
constexpr int SEG1 = 9, NSEG1 = 15;
__device__ __forceinline__ void gdn_chain(LAS uchar* lds, float* Q, const float* Pm, const int half, const int tid) {
    const int wid = __builtin_amdgcn_readfirstlane(tid >> 6), lane = tid & 63, fr = lane & 15, fq = lane >> 4, dvw = half * 128 + 16 * wid;
    f32x4 S[8];
#pragma unroll
    for (int m = 0; m < 8; ++m) S[m] = (f32x4){0.f, 0.f, 0.f, 0.f};
    f32x4 pp[8];
    {
        int tl0 = tid; asm volatile("" : "+v"(tl0));
#pragma unroll
        for (int i = 0; i < 8; ++i) { const int idx = tl0 + 512 * i; pp[i] = *(const f32x4*)(Pm + (idx >> 5) * 128 + 4 * (idx & 31)); }
    }
#pragma unroll 1
    for (int j = 0; j < NSEG0 - 1; ++j) {
        __syncthreads();
        int tl = tid; asm volatile("" : "+v"(tl));
#pragma unroll
        for (int i = 0; i < 8; ++i) {
            const int idx = tl + 512 * i, row = idx >> 5, c4 = idx & 31;
            u32x2 o = {cvt_pk_bf16(pp[i][0], pp[i][1]), cvt_pk_bf16(pp[i][2], pp[i][3])};
            *(LAS u32x2*)(lds + (row * QS + 4 * c4) * 2) = o;
        }
        if (j + 1 < NSEG0 - 1) {
            const float* Pn = Pm + (size_t)(j + 1) * 16384;
#pragma unroll
            for (int i = 0; i < 8; ++i) { const int idx = tl + 512 * i; pp[i] = *(const f32x4*)(Pn + (idx >> 5) * 128 + 4 * (idx & 31)); }
        }
        float* Qj = Q + (size_t)j * 32768 + (size_t)(4 * fq) * 256 + dvw + fr;
        f32x4 Qv[8];
#pragma unroll
        for (int m = 0; m < 8; ++m)
#pragma unroll
            for (int jj = 0; jj < 4; ++jj) Qv[m][jj] = Qj[(16 * m + jj) * 256];
        __syncthreads();
        f32x4 Sn[8];
#pragma unroll
        for (int m = 0; m < 8; ++m) Sn[m] = (f32x4){0.f, 0.f, 0.f, 0.f};
        LB(pb, (fr * QS + 4 * fq) * 2);
#pragma unroll
        for (int ks = 0; ks < 4; ++ks) {
            const bf16x8 b0 = pack8(S[2 * ks], S[2 * ks + 1]);
#pragma unroll
            for (int m = 0; m < 8; ++m) {
                const LAS uchar* ap = lds + pb + (16 * m * QS + 32 * ks) * 2;
                const bf16x8 a = mk8(*(const LAS u32x2*)ap, *(const LAS u32x2*)(ap + 32));
                Sn[m] = MFMA16(a, b0, Sn[m]);
            }
        }
#pragma unroll
        for (int m = 0; m < 8; ++m)
#pragma unroll
            for (int jj = 0; jj < 4; ++jj) { const float v = Sn[m][jj] + Qv[m][jj]; S[m][jj] = v; Qj[(16 * m + jj) * 256] = v; }
    }
}

#define XB_TMO      128
#define XB_XCNT(j)  (256  + 64 * (j))
#define XB_XSUB(j)  (1280 + 64 * (j))
#define XB_XGEN(j)  (2304 + 64 * (j))
#define XB_TOP      3328
#define XB_TOPGEN   3392
#define XCD_BAR_WORDS 3456
#define XB_SPIN_CAP (1u << 18)

__device__ __forceinline__ unsigned xb_ld(unsigned* p)              { return __hip_atomic_load(p, __ATOMIC_RELAXED, __HIP_MEMORY_SCOPE_AGENT); }
__device__ __forceinline__ unsigned xb_add(unsigned* p, unsigned v) { return __hip_atomic_fetch_add(p, v, __ATOMIC_RELAXED, __HIP_MEMORY_SCOPE_AGENT); }
__device__ __forceinline__ unsigned xb_xcc_id() { return (unsigned)__builtin_amdgcn_s_getreg((3 << 11) | 20) & 0xFu; }
#define XB_SPIN(cond, bar) do { unsigned _sp = 0; while (cond) { __builtin_amdgcn_s_sleep(1); \
    if ((++_sp & 255u) == 0u) { if (xb_ld(&(bar)[XB_TMO])) break; if (_sp > XB_SPIN_CAP) { atomicAdd(&(bar)[XB_TMO], 1u); break; } } } } while (0)

struct XcdBarrier {
    unsigned* bar; unsigned x;
    volatile LAS unsigned* st;
};

__device__ __forceinline__ XcdBarrier xcd_barrier_post(unsigned* bar, volatile LAS unsigned* st) {
    XcdBarrier b; b.bar = bar; b.x = xb_xcc_id(); b.st = st;
    if (threadIdx.x == 0) (void)xb_add(&bar[XB_XCNT(b.x)], 1u);
    return b;
}
__device__ __forceinline__ void xcd_barrier_complete(unsigned* bar, unsigned x, unsigned& nloc, unsigned& nx) {
    const unsigned G = gridDim.x * gridDim.y * gridDim.z;
    unsigned sum, cnt, mine, sp = 0u;
    for (;;) {
        sum = 0u; cnt = 0u; mine = 0u;
#pragma unroll
        for (unsigned j = 0; j < 16; ++j) { const unsigned c = xb_ld(&bar[XB_XCNT(j)]); sum += c; cnt += (c > 0u) ? 1u : 0u; mine = (j == x) ? c : mine; }
        if (sum == G) break;
        __builtin_amdgcn_s_sleep(1);
        if ((++sp & 255u) == 0u) { if (xb_ld(&bar[XB_TMO])) break; if (sp > XB_SPIN_CAP) { atomicAdd(&bar[XB_TMO], 1u); break; } }
    }
    nloc = mine > 0u ? mine : 1u; nx = cnt > 0u ? cnt : 1u;
}

__device__ __forceinline__ void xcd_barrier(const XcdBarrier& b) {
    asm volatile("s_waitcnt vmcnt(0)" ::: "memory");
    __syncthreads();
    if (threadIdx.x == 0) {
        unsigned* bar = b.bar;
        __builtin_amdgcn_s_waitcnt(0);
        unsigned nloc = b.st[0], nx = b.st[1];
        if (nloc == 0u) { xcd_barrier_complete(bar, b.x, nloc, nx); b.st[0] = nloc; b.st[1] = nx; }
        const unsigned old = xb_add(&bar[XB_XSUB(b.x)], 1u);
        const unsigned gen = old / nloc;
        if (old + 1u == (gen + 1u) * nloc) {
            __builtin_amdgcn_fence(__ATOMIC_RELEASE, "agent");
            asm volatile("s_waitcnt vmcnt(0)" ::: "memory");
            const unsigned og = xb_add(&bar[XB_TOP], 1u);
            const unsigned tg = og / nx;
            if (og + 1u == (tg + 1u) * nx) xb_add(&bar[XB_TOPGEN], 1u);
            else XB_SPIN(xb_ld(&bar[XB_TOPGEN]) == tg, bar);
            __builtin_amdgcn_fence(__ATOMIC_ACQUIRE, "agent");
            xb_add(&bar[XB_XGEN(b.x)], 1u);
            asm volatile("s_waitcnt vmcnt(0)" ::: "memory");
        } else {
            XB_SPIN(xb_ld(&bar[XB_XGEN(b.x)]) == gen, bar);
            __builtin_amdgcn_fence(__ATOMIC_ACQUIRE, "agent");
            asm volatile("s_waitcnt vmcnt(0)" ::: "memory");
        }
    }
    __syncthreads();
}


template <int SRC, bool WRITE_HB> struct EpiLN {
    static constexpr bool AFTER_DRAIN = true;
    float* Rm; const float* x; const float* lnw; const float* lnb; bf16_t* hb; f32x2* stats;
    __device__ __forceinline__ void fused(f32x4 (&acc)[2][2][4][2], const pg8::Unit& u, int wr, int wc, int fr, int fq, LAS uchar* lds, const int tid, const XcdBarrier& xbar) const {
        LAS f32x2* PT = (LAS f32x2*)lds;
        LAS f32x2* ST = (LAS f32x2*)(lds + 8192);
        const int row0 = u.pm * 256 + wr * 64 + fr, colt = u.pn * 256 + wc * 32 + 8 * fq;
#pragma unroll
        for (int ai = 0; ai < 2; ++ai) {
            f32x4 hv[4][2][2];
#pragma unroll
            for (int m = 0; m < 4; ++m) {
                const float* hp = (SRC == 0 ? x : Rm) + (size_t)(row0 + ai * 128 + m * 16) * DM + colt;
#pragma unroll
                for (int bj = 0; bj < 2; ++bj) { hv[m][bj][0] = *(const f32x4*)(hp + bj * 128); hv[m][bj][1] = *(const f32x4*)(hp + bj * 128 + 4); }
            }
#pragma unroll
            for (int m = 0; m < 4; ++m) {
                float s1 = 0.f, s2 = 0.f;
#pragma unroll
                for (int bj = 0; bj < 2; ++bj) {
                    const f32x4 v0 = hv[m][bj][0] * DN_ALPHA + acc[ai][bj][m][0], v1 = hv[m][bj][1] * DN_ALPHA + acc[ai][bj][m][1];
                    acc[ai][bj][m][0] = v0; acc[ai][bj][m][1] = v1;
#pragma unroll
                    for (int e = 0; e < 4; ++e) { s1 += v0[e] + v1[e]; s2 += v0[e] * v0[e] + v1[e] * v1[e]; }
                }
                s1 += __shfl_xor(s1, 16); s1 += __shfl_xor(s1, 32); s2 += __shfl_xor(s2, 16); s2 += __shfl_xor(s2, 32);
                if (fq == 0) PT[(ai * 128 + wr * 64 + m * 16 + fr) * 4 + wc] = (f32x2){s1, s2};
            }
            __builtin_amdgcn_sched_barrier(0);
        }
        __syncthreads();
        if (tid < 256) {
            const f32x2 a = PT[tid * 4 + 0], b = PT[tid * 4 + 1], c = PT[tid * 4 + 2], d = PT[tid * 4 + 3];
            stats[(size_t)(u.pm * 256 + tid) * 4 + u.pn] = (f32x2){(a[0] + b[0]) + (c[0] + d[0]), (a[1] + b[1]) + (c[1] + d[1])};
        }
        xcd_barrier(xbar);
        if (tid < 256) {
            const f32x2* sp = stats + (size_t)(u.pm * 256 + tid) * 4;
            const f32x2 a = sp[0], b = sp[1], c = sp[2], d = sp[3];
            const float mean = ((a[0] + b[0]) + (c[0] + d[0])) * (1.f / DM);
            const float var = fmaxf(((a[1] + b[1]) + (c[1] + d[1])) * (1.f / DM) - mean * mean, 0.f);
            ST[tid] = (f32x2){mean, 1.f / sqrtf(var + 1e-5f)};
        }
        __syncthreads();
        f32x4 wv[2][2], bv[2][2];
#pragma unroll
        for (int bj = 0; bj < 2; ++bj)
#pragma unroll
            for (int n = 0; n < 2; ++n) { wv[bj][n] = *(const f32x4*)(lnw + colt + bj * 128 + 4 * n); bv[bj][n] = *(const f32x4*)(lnb + colt + bj * 128 + 4 * n); }
#pragma unroll
        for (int ai = 0; ai < 2; ++ai)
#pragma unroll
            for (int m = 0; m < 4; ++m) {
                const int rl = ai * 128 + wr * 64 + m * 16 + fr, row = u.pm * 256 + rl;
                const f32x2 ms = ST[rl];
                float* rp = Rm + (size_t)row * DM + colt;
#pragma unroll
                for (int bj = 0; bj < 2; ++bj) {
                    const f32x4 y0 = (acc[ai][bj][m][0] - ms[0]) * ms[1] * wv[bj][0] + bv[bj][0], y1 = (acc[ai][bj][m][1] - ms[0]) * ms[1] * wv[bj][1] + bv[bj][1];
                    *(f32x4*)(rp + bj * 128) = y0; *(f32x4*)(rp + bj * 128 + 4) = y1;
                    if (WRITE_HB) { u32x4 w = {cvt_pk_bf16(y0[0], y0[1]), cvt_pk_bf16(y0[2], y0[3]), cvt_pk_bf16(y1[0], y1[1]), cvt_pk_bf16(y1[2], y1[3])}; *(u32x4*)(hb + (size_t)row * DM + colt + bj * 128) = w; }
                }
                __builtin_amdgcn_sched_barrier(0);
            }
    }
};
__device__ __forceinline__ void ln_tail_row(float* rp, const float* w, const float* bia, bf16_t* hbrow, const int lane) {
    f32x4 v[4]; float s = 0.f;
#pragma unroll
    for (int j = 0; j < 4; ++j) { v[j] = ((const f32x4*)rp)[lane + 64 * j]; s += (v[j][0] + v[j][1]) + (v[j][2] + v[j][3]); }
    const float mean = wave_sum(s) * (1.f / DM); float s2 = 0.f;
#pragma unroll
    for (int j = 0; j < 4; ++j) { v[j] = v[j] - mean; s2 += (v[j][0] * v[j][0] + v[j][1] * v[j][1]) + (v[j][2] * v[j][2] + v[j][3] * v[j][3]); }
    const float rstd = 1.f / sqrtf(wave_sum(s2) * (1.f / DM) + 1e-5f);
#pragma unroll
    for (int j = 0; j < 4; ++j) {
        const f32x4 y = v[j] * rstd * ((const f32x4*)w)[lane + 64 * j] + ((const f32x4*)bia)[lane + 64 * j];
        ((f32x4*)rp)[lane + 64 * j] = y;
        u32x2 o = {cvt_pk_bf16(y[0], y[1]), cvt_pk_bf16(y[2], y[3])}; ((u32x2*)hbrow)[lane + 64 * j] = o;
    }
}

__global__ void __launch_bounds__(NTHREADS, 2) mega_fwd(Params p) {
    extern __shared__ __attribute__((aligned(16))) uchar lds_raw[];
    LAS uchar* lds = (LAS uchar*)lds_raw;
    cg::grid_group grid = cg::this_grid();
    const int bid = blockIdx.x, nb = gridDim.x;
    const int wave0 = __builtin_amdgcn_readfirstlane((int)threadIdx.x >> 6);
    volatile LAS unsigned* MISC = (volatile LAS unsigned*)(lds + 131072);
    if (threadIdx.x < 2) MISC[threadIdx.x] = 0u;
    __syncthreads();
    const XcdBarrier xb = xcd_barrier_post((unsigned*)(p.ws + OFF_BAR), MISC);
#define GSYNC() xcd_barrier(xb)
#define PHASE_VARS \
    int tid; asm volatile("v_mbcnt_lo_u32_b32 %0, -1, 0\n\tv_mbcnt_hi_u32_b32 %0, -1, %0" : "=v"(tid)); tid += wave0 * 64; \
    uchar* ws = p.ws; asm volatile("" : "+s"(ws)); int nbl = nb; asm volatile("" : "+s"(nbl)); (void)nbl; \
    float* Rm = p.out; asm volatile("" : "+s"(Rm)); \
    bf16_t* HB = (bf16_t*)(ws + OFF_HB); bf16_t* Yb = (bf16_t*)(ws + OFF_Y); bf16_t* Pb = (bf16_t*)(ws + OFF_P); \
    bf16_t* WA = (bf16_t*)(ws + OFF_WA); bf16_t* WO = (bf16_t*)(ws + OFF_WOUT); bf16_t* WSM = (bf16_t*)(ws + OFF_WSM); \
    bf16_t* W1t = (bf16_t*)(ws + OFF_TINV); bf16_t* W2t = (bf16_t*)(ws + OFF_WA); f32x2* lnstats = (f32x2*)(ws + OFF_SIDE); \
    float* Rt = (float*)(ws + OFF_RT); float* side = (float*)(ws + OFF_SIDE); \
    (void)HB; (void)Yb; (void)Pb; (void)WA; (void)WO; (void)WSM; (void)W1t; (void)W2t; (void)lnstats; (void)Rt; (void)side; (void)Rm;
    const int lo = p.ph_lo, hi = p.ph_hi;
#define IN(k) (lo <= (k) && (k) < hi)
#define REPEAT(n) for (int rep_ = 0; rep_ < (n); ++rep_, (rep_ < (n) ? GSYNC() : (void)0))
#define SEAM(k) do { if (IN(k) && IN((k) + 1)) GSYNC(); } while (0)
    if (lo > hi) grid.sync();

    if (IN(0)) REPEAT(REP0) {
        PHASE_VARS
        {
            const int lane = tid & 63, gw = bid * 8 + (tid >> 6), NGW = nb * 8;
            for (int row0 = gw; row0 < MROWS; row0 += 4 * NGW) {
                f32x4 v[4][4];
#pragma unroll
                for (int q = 0; q < 4; ++q) {
                    const int row = row0 + q * NGW;
                    if (row < MROWS) {
                        const float* xp = row < MMAIN ? p.in[I_X] + (size_t)row * DM : p.in[I_META] + (size_t)(row - MMAIN) * DM;
#pragma unroll
                        for (int j = 0; j < 4; ++j) v[q][j] = ((const f32x4*)xp)[lane + 64 * j];
                    }
                }
#pragma unroll
                for (int q = 0; q < 4; ++q) {
                    const int row = row0 + q * NGW;
                    if (row < MROWS) {
#pragma unroll
                        for (int j = 0; j < 4; ++j) { u32x2 o = {cvt_pk_bf16(v[q][j][0], v[q][j][1]), cvt_pk_bf16(v[q][j][2], v[q][j][3])}; ((u32x2*)(HB + (size_t)row * DM))[lane + 64 * j] = o; }
                    }
                }
            }
        }
        {
            const float* w = p.in[I_ABWIN];
            const TSeg segs[5] = {{w, 6152, 0, 2048, 1024, WA, 0}, {w, 6152, 3072, 2048, 1024, WA, 2048}, {w, 6152, 2048, 1024, 1024, WA, 4096}, {w, 6152, 5128, 1024, 1024, WA, 5120},
                                  {p.in[I_ABWOUT], 1024, 0, 1024, 2048, WO, 0}};
            transpose_segs<5>(lds, segs, tid);
        }
        for (int i = bid * NTHREADS + tid; i < 32 * 1024; i += nbl * NTHREADS) {
            const int r = i >> 10, k = i & 1023;
            WSM[i] = r < 8 ? (bf16_t)f2bf(p.in[I_ABWIN][(size_t)k * 6152 + 5120 + r]) : (bf16_t)0;
        }
        for (int i = bid * NTHREADS + tid; i < 8256 * 64; i += nbl * NTHREADS) {
            const int L = i >> 6, d = i & 63;
            const float pos = (float)(L - 48);
            const float invf = 1.0f / powf(10000.0f, (float)d * (1.0f / 63.0f));
            const float ang = pos * invf;
            const double ad = (double)ang; const double kk = rint(ad * 0.15915494309189535); const double r = ad - kk * 6.283185307179586;
            float sn, cs; __sincosf((float)r, &sn, &cs);
            ((f32x2*)(ws + OFF_CS))[i] = (f32x2){cs, sn};
        }
    }
    SEAM(0);
    if (IN(1)) REPEAT(REP1) {
        PHASE_VARS
        Epi<0> E{Pb, 4096, 4096, Yb, 2048, nullptr, nullptr, nullptr, nullptr, nullptr};
        Epi<4> Es{nullptr, 0, 0, nullptr, 0, nullptr, nullptr, nullptr, nullptr, side};
        skinny_gemm<1>(lds, HB, DM, WA, DM, MMAIN, 1, 6144 / 32, E, bid, nb, tid);
        skinny_gemm<4>(lds, HB, DM, WSM, DM, 0, MROWS / 16, 1, Es, bid, nb, tid);
        pg8::Gemm g{HB, WA, MMAIN, 6144, DM}; pg8::StaticOrder S; S.init(MMAIN, 6144, nb, bid);
#ifndef NO_GEMM
        pg8::gemm_phase(lds, g, S, E, tid, xb);
#endif
    }
    SEAM(1);
#ifndef NO_TINV
    if (IN(2)) {
        { PHASE_VARS halo_save(Pb, 4096, 2048, 256, HB, tid); }
        GSYNC();
        { PHASE_VARS conv_inplace<0>(Pb, 4096, 2048, 256, HB, p, tid); rope_inplace(Pb, ws, tid); }
        GSYNC();
        REPEAT(REP2) { PHASE_VARS tinv_phase(lds, p, ws, tid); }
    }
#endif
    SEAM(2);
    if (IN(3)) REPEAT(REP3) {
        PHASE_VARS
        float* RQ = (float*)(ws + OFF_HB); float* GQ = RQ + 8 * 10 * 32768; float* GP = GQ + 8 * 10 * 32768;
        for (int u = bid; u < 240; u += nb) {
            const int kind = u / 80, r = u % 80, unit = r / 10, seg = r % 10, b = unit >> 2, h = unit & 3, c0 = seg * SEG0, c1 = c0 + SEG0;
            if (kind == 0) { int tid2 = tid; asm volatile("" : "+v"(tid2)); scan_unit<0, 1, 2>(lds, p, ws, b, h, c0, c1, nullptr, RQ + (size_t)(unit * 10 + seg) * 32768, nullptr, tid2); }
            else if (kind == 1) { int tid2 = tid; asm volatile("" : "+v"(tid2)); scan_unit<1, 1, 2>(lds, p, ws, b, h, c0, c1, nullptr, GQ + (size_t)(unit * 10 + seg) * 32768, nullptr, tid2); }
            else { int tid2 = tid; asm volatile("" : "+v"(tid2)); scan_unit<3, 1, 1>(lds, p, ws, b, h, c0, c1, nullptr, GP + (size_t)(unit * 10 + seg) * 16384, nullptr, tid2); }
        }
    }
    SEAM(3);
    if (IN(4)) {
        PHASE_VARS
        float* RQ = (float*)(ws + OFF_HB); float* GQ = RQ + 8 * 10 * 32768; float* GP = GQ + 8 * 10 * 32768;
        if (bid < 16) gdn_chain(lds, GQ + (size_t)(bid >> 1) * 10 * 32768, GP + (size_t)(bid >> 1) * 10 * 16384, bid & 1, tid);
        else {
            for (int e = (bid - 16) * NTHREADS + tid; e < 8 * 32768 / 4; e += (nbl - 16) * NTHREADS) {
                const int unit = e >> 13, off = (e & 8191) * 4;
                const float d = __expf(log1pf(-exp2f(-5.f - (float)(unit & 3))) * (64.f * SEG0));
                float* q = RQ + (size_t)unit * 10 * 32768 + off;
                f32x4 qv[NSEG0 - 1];
#pragma unroll
                for (int j = 0; j < NSEG0 - 1; ++j) qv[j] = *(const f32x4*)(q + (size_t)j * 32768);
                f32x4 S = {0.f, 0.f, 0.f, 0.f};
#pragma unroll
                for (int j = 0; j < NSEG0 - 1; ++j) { S = S * d + qv[j]; *(f32x4*)(q + (size_t)j * 32768) = S; }
            }
        }
    }
    SEAM(4);
    if (IN(5)) {
        PHASE_VARS
        float* RQ = (float*)(ws + OFF_HB); float* GQ = RQ + 8 * 10 * 32768;
        for (int u = bid; u < 256; u += nb) {
            if (u < 88) {
                const int unit = u / NSEG0, seg = u % NSEG0, b = unit >> 2, h = unit & 3, c0 = seg * SEG0, c1 = (c0 + SEG0 < NCHUNK) ? c0 + SEG0 : NCHUNK;
                int tid2 = tid; asm volatile("" : "+v"(tid2));
                scan_unit<0, 0, 2, false, true, true>(lds, p, ws, b, h, c0, c1, seg > 0 ? RQ + (size_t)(unit * 10 + seg - 1) * 32768 : nullptr, nullptr, nullptr, tid2);
            } else {
                int unit, seg, c0, c1, cfull;
                if (u < 248) { const int idx = (u - 88) % 80, half = (u - 88) / 80; unit = idx / 10; seg = idx % 10; c0 = seg * SEG0; c1 = half ? c0 + SEG0 : c0 + SEG0 / 2; cfull = half ? c0 + SEG0 / 2 : c0; }
                else { unit = u - 248; seg = 10; c0 = seg * SEG0; c1 = NCHUNK; cfull = c0; }
                int tid2 = tid; asm volatile("" : "+v"(tid2));
                scan_unit<1, 0, 2, true, true, false>(lds, p, ws, unit >> 2, unit & 3, c0, c1, seg > 0 ? GQ + (size_t)(unit * 10 + seg - 1) * 32768 : nullptr, nullptr, nullptr, tid2, cfull);
            }
        }
    }
    SEAM(5);
    if (IN(6)) {
        PHASE_VARS
        {
            const TSeg segs[2] = {{p.in[I_W1], DFF, 0, DFF, DM, W1t, 0}, {p.in[I_W2], DM, 0, DM, DFF, W2t, 0}};
            transpose_segs<2>(lds, segs, tid);
        }
        __syncthreads();
        Epi<2> Et{nullptr, 0, 0, nullptr, 0, Rm, Rt, p.in[I_X], p.in[I_META], nullptr};
        skinny_gemm<1>(lds, Yb, 2048, WO, 2048, MMAIN, 1, DM / 32, Et, bid, nb, tid);
        EpiLN<0, true> E{Rm, p.in[I_X], p.in[I_LN1W], p.in[I_LN1B], HB, lnstats};
        pg8::Gemm g{Yb, WO, MMAIN, DM, 2048}; pg8::StaticOrder S; S.init(MMAIN, DM, nb, bid);
        pg8::gemm_phase(lds, g, S, E, tid, xb);
        if (bid < 16 && tid < 64) ln_tail_row(Rt + (size_t)bid * DM, p.in[I_LN1W], p.in[I_LN1B], HB + (size_t)(MMAIN + bid) * DM, tid);
    }
    SEAM(6);
#pragma unroll
    for (int layer = 0; layer < 2; ++layer) {
        const int pb = layer == 0 ? 7 : 17;
        if (IN(pb + 1)) {
            PHASE_VARS
            Epi<1> E{Pb, DFF, 0, nullptr, 0, nullptr, nullptr, nullptr, nullptr, nullptr};
            skinny_gemm<1>(lds, HB, DM, W1t, DM, MMAIN, 1, DFF / 32, E, bid, nb, tid);
            pg8::Gemm g{HB, W1t, MMAIN, DFF, DM}; pg8::StaticOrder S; S.init(MMAIN, DFF, nb, bid);
            pg8::gemm_phase(lds, g, S, E, tid, xb);
        }
        SEAM(pb + 1);
        if (IN(pb + 2)) {
            PHASE_VARS
            pg8::Gemm g{Pb, W2t, MMAIN, DM, DFF}; pg8::StaticOrder S; S.init(MMAIN, DM, nb, bid);
            if (layer == 0) {
                Epi<3> Et{nullptr, 0, 0, nullptr, 0, Rm, Rt, nullptr, nullptr, nullptr};
                skinny_gemm<1>(lds, Pb, DFF, W2t, DFF, MMAIN, 1, DM / 32, Et, bid, nb, tid);
                EpiLN<1, true> E{Rm, nullptr, p.in[I_LN2W], p.in[I_LN2B], HB, lnstats};
                pg8::gemm_phase(lds, g, S, E, tid, xb);
                if (bid < 16 && tid < 64) ln_tail_row(Rt + (size_t)bid * DM, p.in[I_LN2W], p.in[I_LN2B], HB + (size_t)(MMAIN + bid) * DM, tid);
                {
                    __syncthreads();
                    int tid3 = tid; asm volatile("" : "+v"(tid3));
                    const float* w = p.in[I_CWIN];
                    const TSeg segs[3] = {{w, 5152, 2048, 3072, 1024, WA, 0}, {w, 5152, 0, 2048, 1024, WA, 3072}, {p.in[I_CWOUT], 1024, 0, 1024, 2048, WO, 0}};
                    transpose_segs<3>(lds, segs, tid3);
                    for (int i = bid * NTHREADS + tid3; i < 32 * 1024; i += nbl * NTHREADS) { const int r = i >> 10, k = i & 1023; WSM[i] = (bf16_t)f2bf(w[(size_t)k * 5152 + 5120 + r]); }
                }
            } else {
                EpiLN<1, false> E{Rm, nullptr, p.in[I_LN2W] + DM, p.in[I_LN2B] + DM, HB, lnstats};
                pg8::gemm_phase(lds, g, S, E, tid, xb);
            }
        }
        SEAM(pb + 2);
        if (layer == 0) {
            if (IN(11)) REPEAT(REP11) {
                PHASE_VARS
                Epi<0> E{Pb, 3072, 3072, Yb, 2048, nullptr, nullptr, nullptr, nullptr, nullptr};
                Epi<4> Es{nullptr, 0, 0, nullptr, 0, nullptr, nullptr, nullptr, nullptr, side};
                skinny_gemm<1>(lds, HB, DM, WA, DM, MMAIN, 1, 5120 / 32, E, bid, nb, tid);
                skinny_gemm<4>(lds, HB, DM, WSM, DM, 0, MROWS / 16, 1, Es, bid, nb, tid);
                pg8::Gemm g{HB, WA, MMAIN, 5120, DM}; pg8::StaticOrder S; S.init(MMAIN, 5120, nb, bid);
                pg8::gemm_phase(lds, g, S, E, tid, xb);
            }
            SEAM(11);
            if (IN(12)) {
                { PHASE_VARS halo_save(Pb, 3072, 0, 384, HB, tid); }
                GSYNC();
                { PHASE_VARS conv_inplace<1>(Pb, 3072, 0, 384, HB, p, tid); }
                GSYNC();
            }
            if (IN(12)) REPEAT(REP12) {
                PHASE_VARS
                float* SQ = (float*)(ws + OFF_HB); float* SG = SQ + (size_t)16 * 14 * 32768;
                for (int u = bid; u < 224; u += nb) {
                    const int unit = u / 14, seg = u % 14, c0 = seg * SEG1;
                    int tid2 = tid; asm volatile("" : "+v"(tid2));
                    scan_unit<2, 1, 2>(lds, p, ws, unit >> 3, unit & 7, c0, c0 + SEG1, nullptr, SQ + (size_t)(unit * 14 + seg) * 32768, SG + (unit * 14 + seg) * 4, tid2);
                }
            }
            SEAM(12);
            if (IN(13)) {
                PHASE_VARS
                float* SQ = (float*)(ws + OFF_HB); float* SG = SQ + (size_t)16 * 14 * 32768;
                for (int e = bid * NTHREADS + tid; e < 16 * 32768 / 4; e += nbl * NTHREADS) {
                    const int unit = e >> 13, off = (e & 8191) * 4, hq = (off & 255) >> 6;
                    float* q = SQ + (size_t)unit * 14 * 32768 + off;
                    f32x4 qv[NSEG1 - 1]; float dg[NSEG1 - 1];
#pragma unroll
                    for (int j = 0; j < NSEG1 - 1; ++j) { qv[j] = *(const f32x4*)(q + (size_t)j * 32768); dg[j] = SG[(unit * 14 + j) * 4 + hq]; }
                    f32x4 S = {0.f, 0.f, 0.f, 0.f};
#pragma unroll
                    for (int j = 0; j < NSEG1 - 1; ++j) { S = S * __expf(dg[j]) + qv[j]; *(f32x4*)(q + (size_t)j * 32768) = S; }
                }
            }
            SEAM(13);
            if (IN(14)) {
                PHASE_VARS
                float* SQ = (float*)(ws + OFF_HB);
                for (int u = bid; u < 240; u += nb) {
                    const int unit = u / NSEG1, seg = u % NSEG1, c0 = seg * SEG1, c1 = (c0 + SEG1 < NCHUNK) ? c0 + SEG1 : NCHUNK;
                    int tid2 = tid; asm volatile("" : "+v"(tid2));
                    scan_unit<2, 0, 2>(lds, p, ws, unit >> 3, unit & 7, c0, c1, seg > 0 ? SQ + (size_t)(unit * 14 + seg - 1) * 32768 : nullptr, nullptr, nullptr, tid2);
                }
            }
            SEAM(14);
            if (IN(15)) { PHASE_VARS rmsnorm_phase(Yb, p.in[I_CNORMW], tid); }
            SEAM(15);
            if (IN(16)) {
                PHASE_VARS
                {
                    const TSeg segs[2] = {{p.in[I_W1] + (size_t)DM * DFF, DFF, 0, DFF, DM, W1t, 0}, {p.in[I_W2] + (size_t)DM * DFF, DM, 0, DM, DFF, W2t, 0}};
                    transpose_segs<2>(lds, segs, tid);
                }
                __syncthreads();
                Epi<3> Et{nullptr, 0, 0, nullptr, 0, Rm, Rt, nullptr, nullptr, nullptr};
                skinny_gemm<1>(lds, Yb, 2048, WO, 2048, MMAIN, 1, DM / 32, Et, bid, nb, tid);
                EpiLN<1, true> E{Rm, nullptr, p.in[I_LN1W] + DM, p.in[I_LN1B] + DM, HB, lnstats};
                pg8::Gemm g{Yb, WO, MMAIN, DM, 2048}; pg8::StaticOrder S; S.init(MMAIN, DM, nb, bid);
                pg8::gemm_phase(lds, g, S, E, tid, xb);
                if (bid < 16 && tid < 64) ln_tail_row(Rt + (size_t)bid * DM, p.in[I_LN1W] + DM, p.in[I_LN1B] + DM, HB + (size_t)(MMAIN + bid) * DM, tid);
            }
            SEAM(16);
        }
    }
#undef IN
#undef SEAM
}

#ifndef MK_PER_PHASE
#define MK_PER_PHASE 0
#endif
extern "C" void kernel_launch(void* const* d_in, const int* in_sizes, int n_in, void* d_out, int out_size, void* d_ws, size_t ws_size, hipStream_t stream) {
    static int grid = 0;
    if (grid == 0) {
        if (n_in != 25 || ws_size < WS_END || out_size != MMAIN * DM) { fprintf(stderr, "kernel_launch: unexpected shapes (n_in %d ws %zu out %d)\n", n_in, ws_size, out_size); grid = -1; return; }
        int dev = 0, cus = 0, per_cu = 0;
        hipGetDevice(&dev);
        hipDeviceGetAttribute(&cus, hipDeviceAttributeMultiprocessorCount, dev);
        if (hipFuncSetAttribute((const void*)mega_fwd, hipFuncAttributeMaxDynamicSharedMemorySize, LDS_BYTES) != hipSuccess) { fprintf(stderr, "kernel_launch: hipFuncSetAttribute failed\n"); grid = -1; return; }
        if (hipOccupancyMaxActiveBlocksPerMultiprocessor(&per_cu, (const void*)mega_fwd, NTHREADS, LDS_BYTES) != hipSuccess || per_cu < 1) { fprintf(stderr, "kernel_launch: occupancy query says %d\n", per_cu); grid = -1; return; }
        grid = cus * (per_cu > 1 ? 1 : per_cu);
        fprintf(stderr, "kernel_launch: grid %d (cus %d per_cu %d)\n", grid, cus, per_cu);
    }
    if (grid < 0) return;
    if (hipMemsetAsync((char*)d_ws + OFF_BAR, 0, 16384, stream) != hipSuccess) { fprintf(stderr, "kernel_launch: memset failed\n"); return; }
    Params p{};
    for (int i = 0; i < 25; ++i) p.in[i] = (const float*)d_in[i];
    p.out = (float*)d_out; p.ws = (uchar*)d_ws;
#if MK_PER_PHASE
    for (int ph = 0; ph < 21; ++ph) {
        p.ph_lo = ph; p.ph_hi = ph + 1;
        void* args[] = {&p};
        hipError_t e = hipLaunchCooperativeKernel((const void*)mega_fwd, dim3(grid), dim3(NTHREADS), args, LDS_BYTES, stream);
        if (e != hipSuccess) { fprintf(stderr, "cooperative launch failed: %s\n", hipGetErrorString(e)); break; }
    }
#else
    p.ph_lo = 0; p.ph_hi = 20;
    void* args[] = {&p};
    hipError_t e = hipLaunchCooperativeKernel((const void*)mega_fwd, dim3(grid), dim3(NTHREADS), args, LDS_BYTES, stream);
    if (e != hipSuccess) fprintf(stderr, "cooperative launch failed: %s (grid %d)\n", hipGetErrorString(e), grid);
#endif
}
```

```cpp
#include <hip/hip_runtime.h>
#include <hip/hip_cooperative_groups.h>
#include <cstdio>
#include <cstdint>
namespace cg = cooperative_groups;

#define LAS __attribute__((address_space(3)))
typedef unsigned short bf16_t;
typedef short bf16x8 __attribute__((ext_vector_type(8)));
typedef float f32x4 __attribute__((ext_vector_type(4)));
typedef float f32x2 __attribute__((ext_vector_type(2)));
typedef unsigned u32x4 __attribute__((ext_vector_type(4)));
typedef unsigned u32x2 __attribute__((ext_vector_type(2)));
typedef unsigned char uchar;

constexpr int DM = 1024, SEQ = 8192, MMAIN = 16384, MROWS = 16400, NCHUNK = 129, DFF = 4096;
constexpr float DN_ALPHA = 1.41421356237309515f;
constexpr int NTHREADS = 512;
#define REP1 1
#define REP0 1
#define REPT 1
#define REP2 1
#define REP3 1
#define REP8 1
#define REP11 1
#define REP12 1
constexpr int LDS_BYTES = 133120;

constexpr size_t OFF_CS = 0;
constexpr size_t OFF_SIDE = 4227072;
constexpr size_t OFF_RT = 6326272;
constexpr size_t OFF_WSM = 6391808;
constexpr size_t OFF_TINV = 6457344;
constexpr size_t OFF_HB = 14911488;
constexpr size_t OFF_Y = 48498688;
constexpr size_t OFF_P = 115673088;
constexpr size_t OFF_WA = 250021888;
constexpr size_t OFF_WOUT = OFF_WA + 12582912;
constexpr size_t WS_END = OFF_WA + 16777216 + 16384;
constexpr size_t OFF_BAR = OFF_WA + 16777216;

struct Params {
    const float* in[25];
    float* out;
    uchar* ws;
    int ph_lo, ph_hi;
};
enum { I_X = 0, I_META, I_ABWIN, I_RETGN, I_CONVQ, I_CONVK, I_CONVV, I_ABALOG, I_ABDTB, I_GDNNW, I_ABWOUT, I_CWIN, I_CCONVW, I_CCONVB, I_CALOG, I_CDTB, I_CD, I_CNORMW, I_CWOUT,
       I_W1, I_W2, I_LN1W, I_LN1B, I_LN2W, I_LN2B };

__device__ __forceinline__ float bf2f(unsigned h) { return __uint_as_float(h << 16); }
typedef __bf16 bf16x2_t __attribute__((ext_vector_type(2)));
__device__ __forceinline__ unsigned cvt_pk_bf16(float lo, float hi) { f32x2 v = {lo, hi}; bf16x2_t b = __builtin_convertvector(v, bf16x2_t); return __builtin_bit_cast(unsigned, b); }
__device__ __forceinline__ unsigned f2bf(float f) { return cvt_pk_bf16(f, 0.f) & 0xffffu; }
__device__ __forceinline__ float siluf(float x) { return x * __builtin_amdgcn_rcpf(1.f + __expf(-x)); }
__device__ __forceinline__ float softplusf(float x) { return x > 20.f ? x : log1pf(__expf(x)); }
__device__ __forceinline__ int tok_row(int b, int L) { return L < 64 ? (MMAIN + L - 48) : (b * SEQ + L - 64); }
__device__ __forceinline__ bf16x8 mk8(u32x2 lo, u32x2 hi) { u32x4 v = {lo.x, lo.y, hi.x, hi.y}; return __builtin_bit_cast(bf16x8, v); }
__device__ __forceinline__ bf16x8 pack8(f32x4 a, f32x4 b) { u32x4 v = {cvt_pk_bf16(a[0], a[1]), cvt_pk_bf16(a[2], a[3]), cvt_pk_bf16(b[0], b[1]), cvt_pk_bf16(b[2], b[3])}; return __builtin_bit_cast(bf16x8, v); }
__device__ __forceinline__ float row16_sum(float v) {
    v += __builtin_bit_cast(float, __builtin_amdgcn_update_dpp(0, __builtin_bit_cast(int, v), 0xB1, 0xF, 0xF, true));
    v += __builtin_bit_cast(float, __builtin_amdgcn_update_dpp(0, __builtin_bit_cast(int, v), 0x4E, 0xF, 0xF, true));
    v += __builtin_bit_cast(float, __builtin_amdgcn_update_dpp(0, __builtin_bit_cast(int, v), 0x141, 0xF, 0xF, true));
    v += __builtin_bit_cast(float, __builtin_amdgcn_update_dpp(0, __builtin_bit_cast(int, v), 0x140, 0xF, 0xF, true));
    return v;
}
#define MFMA16(a, b, c) __builtin_amdgcn_mfma_f32_16x16x32_bf16((a), (b), (c), 0, 0, 0)

namespace pg8 {
constexpr int BM = 256, BK = 64, HALF = 128, HTB = HALF * BK * 2, STAGE_BYTES = 8 * HTB, NXCD = 8, WGM = 8;
__host__ __device__ __forceinline__ int lds_byte(int r, int c) { const int st = (r >> 4) * 2 + (c >> 5), rr = r & 15, cc = c & 31, ob = rr * 64 + cc * 2; return st * 1024 + (ob ^ (((ob >> 9) & 1) << 5)); }
__host__ __device__ __forceinline__ void stage_rc(int b, int& R, int& C) { const int st = b / 1024, sb = b % 1024, swz = sb ^ (((sb >> 9) & 1) << 5); R = (st >> 1) * 16 + swz / 64; C = (st & 1) * 32 + (swz % 64) / 2; }
__host__ __device__ __forceinline__ int perm32(int rho) { const int n = rho >> 4, i = rho & 15; return 8 * (i >> 2) + 4 * n + (i & 3); }
struct Unit { int pm, pn; };
struct Gemm { const bf16_t* A; const bf16_t* Bt; int M, N, K; };
struct StaticOrder {
    int nM, nN, nwg, G, c;
    __device__ void init(int M, int N, int G_, int c_) { nM = M / BM; nN = N / BM; nwg = nM * nN; G = G_; c = c_; }
    __device__ bool next(int i, Unit& u) const {
        const long L = (long)i * G + c; if (L >= nwg) return false;
        int wgid = (int)L; { const int q = nwg / NXCD, r = nwg % NXCD, xcd = wgid % NXCD, off = wgid / NXCD; wgid = (xcd < r ? xcd * (q + 1) : r * (q + 1) + (xcd - r) * q) + off; }
        const int nig = WGM * nN, gid = wgid / nig, fm = gid * WGM, gsz = (nM - fm) < WGM ? (nM - fm) : WGM;
        u.pm = fm + ((wgid % nig) % gsz); u.pn = (wgid % nig) / gsz; return true;
    }
};

template <class Epi, class XB>
__device__ __forceinline__ void gemm_phase(LAS uchar* lds, const Gemm g, const StaticOrder& S, const Epi& E, const int tid, const XB& xbar) {
    const int wid = __builtin_amdgcn_readfirstlane(tid >> 6), lane = tid & 63, wr = wid >> 2, wc = wid & 3, fr = lane & 15, fq = lane >> 4;
    const int K = g.K, nt = K / BK;
    unsigned voffA[2], voffB[2];
#pragma unroll
    for (int i = 0; i < 2; ++i) { int R, C; stage_rc(tid * 16 + i * 8192, R, C); const int Rb = (R & ~31) + perm32(R & 31);
        voffA[i] = (unsigned)(R * K + C) * 2u; voffB[i] = (unsigned)(Rb * K + C) * 2u; }
    const size_t kstep = (size_t)(BK * 2);
    const size_t hstep = (size_t)HALF * K * 2;
    const size_t tstep = 2 * hstep;
    const unsigned ldsw = (unsigned)wid * 1024u;
    const int aoff = lds_byte(wr * 64 + fr, fq * 8), boff = lds_byte(wc * 32 + fr, fq * 8);
#define PG8_SA(b, h) (((b) * 2 + (h)) * HTB)
#define PG8_SB(b, h) ((4 + (b) * 2 + (h)) * HTB)
#define PG8_STAGE(bufoff, gbase, voff) do { _Pragma("unroll") for (int _i = 0; _i < 2; ++_i) \
        __builtin_amdgcn_global_load_lds((const unsigned*)((const char*)(gbase) + (voff)[_i]), (LAS unsigned*)(lds + (bufoff) + ldsw + _i * 8192), 16, 0, 0); } while (0)
#define PG8_LDA(dst, b, h) do { _Pragma("unroll") for (int m = 0; m < 4; ++m) _Pragma("unroll") for (int k = 0; k < 2; ++k) dst[m][k] = *(const LAS bf16x8*)(lds + PG8_SA(b, h) + aoff + m * 2048 + k * 1024); } while (0)
#define PG8_LDB(dst, b, h) do { _Pragma("unroll") for (int n = 0; n < 2; ++n) _Pragma("unroll") for (int k = 0; k < 2; ++k) dst[n][k] = *(const LAS bf16x8*)(lds + PG8_SB(b, h) + boff + n * 2048 + k * 1024); } while (0)
#define PG8_MMA(ai, bj, At, Bt) do { __builtin_amdgcn_s_setprio(1); _Pragma("unroll") for (int m = 0; m < 4; ++m) _Pragma("unroll") for (int n = 0; n < 2; ++n) _Pragma("unroll") for (int k = 0; k < 2; ++k) \
        acc[ai][bj][m][n] = __builtin_amdgcn_mfma_f32_16x16x32_bf16(Bt[n][k], At[m][k], acc[ai][bj][m][n], 0, 0, 0); __builtin_amdgcn_s_setprio(0); } while (0)
#define PG8_WAIT_V(n) asm volatile("s_waitcnt vmcnt(" #n ")" ::: "memory")
#define PG8_WAIT_L(n) asm volatile("s_waitcnt lgkmcnt(" #n ")" ::: "memory")
#define PG8_BAR __builtin_amdgcn_s_barrier()
#define PG8_SCHED __builtin_amdgcn_sched_barrier(0)
    Unit cur, nxt; int ui = 0;
    if (!S.next(0, cur)) return;
    f32x4 acc[2][2][4][2];
#pragma unroll
    for (int a = 0; a < 2; ++a)
#pragma unroll
        for (int b = 0; b < 2; ++b)
#pragma unroll
            for (int m = 0; m < 4; ++m)
#pragma unroll
                for (int n = 0; n < 2; ++n) acc[a][b][m][n] = (f32x4){0.f, 0.f, 0.f, 0.f};
    bf16x8 At[4][2], B0[2][2], B1[2][2];
    const char* cA = (const char*)g.A + (size_t)cur.pm * tstep; const char* cB = (const char*)g.Bt + (size_t)cur.pn * tstep;
    PG8_STAGE(PG8_SB(0, 0), cB, voffB); PG8_STAGE(PG8_SB(0, 1), cB + hstep, voffB); PG8_STAGE(PG8_SA(0, 0), cA, voffA); PG8_STAGE(PG8_SA(0, 1), cA + hstep, voffA);
    if (wr == 1) PG8_BAR;
    PG8_WAIT_V(2); PG8_BAR;
    PG8_STAGE(PG8_SB(1, 0), cB + kstep, voffB); PG8_STAGE(PG8_SA(1, 0), cA + kstep, voffA); PG8_STAGE(PG8_SB(1, 1), cB + hstep + kstep, voffB);
    PG8_WAIT_V(6); PG8_BAR;
    for (;;) {
        const bool has_next = S.next(ui + 1, nxt);
        const char* nA = has_next ? (const char*)g.A + (size_t)nxt.pm * tstep : cA; const char* nB = has_next ? (const char*)g.Bt + (size_t)nxt.pn * tstep : cB;
        for (int t = 0; t < nt; t += 2) {
            const bool last = (t == nt - 2);
            const char* a1 = cA + (size_t)(t + 1) * kstep;
            const char* a2 = last ? nA : cA + (size_t)(t + 2) * kstep; const char* b2 = last ? nB : cB + (size_t)(t + 2) * kstep;
            const char* a3 = a2 + kstep; const char* b3 = b2 + kstep;
            PG8_LDB(B0, 0, 0); PG8_LDB(B1, 0, 1); PG8_SCHED; PG8_LDA(At, 0, 0); PG8_STAGE(PG8_SA(1, 1), a1 + hstep, voffA);
            PG8_WAIT_V(8); PG8_WAIT_L(0); PG8_BAR; PG8_MMA(0, 0, At, B0); PG8_MMA(0, 1, At, B1); PG8_BAR; PG8_SCHED;
            PG8_LDA(At, 0, 1); PG8_STAGE(PG8_SB(0, 0), b2, voffB); PG8_STAGE(PG8_SB(0, 1), b2 + hstep, voffB); PG8_STAGE(PG8_SA(0, 0), a2, voffA);
            PG8_WAIT_V(8); PG8_WAIT_L(0); PG8_BAR; PG8_MMA(1, 0, At, B0); PG8_MMA(1, 1, At, B1); PG8_BAR; PG8_SCHED;
            PG8_LDB(B0, 1, 0); PG8_LDB(B1, 1, 1); PG8_SCHED; PG8_LDA(At, 1, 0); PG8_STAGE(PG8_SA(0, 1), a2 + hstep, voffA);
            PG8_WAIT_V(8); PG8_WAIT_L(0); PG8_BAR; PG8_MMA(0, 0, At, B0); PG8_MMA(0, 1, At, B1); PG8_BAR; PG8_SCHED;
            PG8_LDA(At, 1, 1); PG8_STAGE(PG8_SB(1, 0), b3, voffB); PG8_STAGE(PG8_SB(1, 1), b3 + hstep, voffB); PG8_STAGE(PG8_SA(1, 0), a3, voffA);
            PG8_WAIT_V(8); PG8_WAIT_L(0); PG8_BAR; PG8_MMA(1, 0, At, B0); PG8_MMA(1, 1, At, B1); PG8_BAR; PG8_SCHED;
        }
        if (wr == 0) PG8_BAR;
        if constexpr (!Epi::AFTER_DRAIN) E(acc, cur, wr, wc, fr, fq);
        if (!has_next) break;
#pragma unroll
        for (int a = 0; a < 2; ++a)
#pragma unroll
            for (int b = 0; b < 2; ++b)
#pragma unroll
                for (int m = 0; m < 4; ++m)
#pragma unroll
                    for (int n = 0; n < 2; ++n) acc[a][b][m][n] = (f32x4){0.f, 0.f, 0.f, 0.f};
        cur = nxt; cA = nA; cB = nB; ++ui;
        if (wr == 1) PG8_BAR;
    }
    PG8_WAIT_V(0);
    PG8_BAR;
    if constexpr (Epi::AFTER_DRAIN) E.fused(acc, cur, wr, wc, fr, fq, lds, tid, xbar);
#undef PG8_SA
#undef PG8_SB
#undef PG8_STAGE
#undef PG8_LDA
#undef PG8_LDB
#undef PG8_MMA
#undef PG8_WAIT_V
#undef PG8_WAIT_L
#undef PG8_BAR
#undef PG8_SCHED
}
}

template <int MODE> struct Epi {
    static constexpr bool AFTER_DRAIN = false;
    bf16_t* o1; int ld1; int split; bf16_t* o2; int ld2; float* Rm; float* Rt; const float* x; const float* meta; float* side;
    __device__ __forceinline__ float* rptr(int row) const { return row < MMAIN ? Rm + (size_t)row * DM : Rt + (size_t)(row - MMAIN) * DM; }
    __device__ __forceinline__ void store4(int row, int col, f32x4 v) const {
        if (MODE == 0) {
            if (col < split) { u32x2 w = {cvt_pk_bf16(v[0], v[1]), cvt_pk_bf16(v[2], v[3])}; *(u32x2*)(o1 + (size_t)row * ld1 + col) = w; }
            else { u32x2 w = {cvt_pk_bf16(siluf(v[0]), siluf(v[1])), cvt_pk_bf16(siluf(v[2]), siluf(v[3]))}; *(u32x2*)(o2 + (size_t)row * ld2 + (col - split)) = w; }
        } else if (MODE == 1) {
            f32x4 r; for (int i = 0; i < 4; ++i) { const float t = fmaxf(v[i], 0.f); r[i] = t * t; }
            u32x2 w = {cvt_pk_bf16(r[0], r[1]), cvt_pk_bf16(r[2], r[3])}; *(u32x2*)(o1 + (size_t)row * ld1 + col) = w;
        } else if (MODE == 2) {
            const float* hp = row < MMAIN ? x + (size_t)row * DM + col : meta + (size_t)(row - MMAIN) * DM + col;
            const f32x4 h = *(const f32x4*)hp; *(f32x4*)(rptr(row) + col) = h * DN_ALPHA + v;
        } else if (MODE == 3) {
            float* rp = rptr(row) + col; const f32x4 h = *(const f32x4*)rp; *(f32x4*)rp = h * DN_ALPHA + v;
        } else {
            if (col < 32) *(f32x4*)(side + (size_t)row * 32 + col) = v;
        }
    }
    __device__ __forceinline__ void operator()(const f32x4 (&acc)[2][2][4][2], const pg8::Unit& u, int wr, int wc, int fr, int fq) const {
        const int row0 = u.pm * 256 + wr * 64 + fr, colt = u.pn * 256 + wc * 32 + 8 * fq;
        if (MODE == 0 || MODE == 1) {
            const bool sec = (MODE == 0) && (u.pn * 256 >= split);
            bf16_t* base = sec ? o2 + (colt - split) : o1 + colt; const int ld = sec ? ld2 : ld1;
#pragma unroll
            for (int ai = 0; ai < 2; ++ai)
#pragma unroll
                for (int m = 0; m < 4; ++m) {
                    bf16_t* rp = base + (size_t)(row0 + ai * 128 + m * 16) * ld;
#pragma unroll
                    for (int bj = 0; bj < 2; ++bj) {
                        f32x4 v0 = acc[ai][bj][m][0], v1 = acc[ai][bj][m][1];
                        if (MODE == 1) {
#pragma unroll
                            for (int i = 0; i < 4; ++i) { const float a = fmaxf(v0[i], 0.f), b = fmaxf(v1[i], 0.f); v0[i] = a * a; v1[i] = b * b; }
                        } else if (sec) {
#pragma unroll
                            for (int i = 0; i < 4; ++i) { v0[i] = siluf(v0[i]); v1[i] = siluf(v1[i]); }
                        }
                        u32x4 w = {cvt_pk_bf16(v0[0], v0[1]), cvt_pk_bf16(v0[2], v0[3]), cvt_pk_bf16(v1[0], v1[1]), cvt_pk_bf16(v1[2], v1[3])};
                        *(u32x4*)(rp + bj * 128) = w;
                    }
                }
        } else {
#pragma unroll
            for (int ai = 0; ai < 2; ++ai)
#pragma unroll
                for (int m = 0; m < 4; ++m) {
                    const int row = row0 + ai * 128 + m * 16;
                    float* rp = Rm + (size_t)row * DM + colt;
                    const float* hp = (MODE == 2) ? x + (size_t)row * DM + colt : rp;
#pragma unroll
                    for (int bj = 0; bj < 2; ++bj) {
                        const f32x4 h0 = *(const f32x4*)(hp + bj * 128), h1 = *(const f32x4*)(hp + bj * 128 + 4);
                        *(f32x4*)(rp + bj * 128) = h0 * DN_ALPHA + acc[ai][bj][m][0]; *(f32x4*)(rp + bj * 128 + 4) = h1 * DN_ALPHA + acc[ai][bj][m][1];
                    }
                    asm volatile("" ::: "memory");
                    __builtin_amdgcn_sched_barrier(0);
                }
        }
    }
};

template <int RT, class E>
__device__ __forceinline__ void skinny_gemm(LAS uchar* lds, const bf16_t* A, int lda, const bf16_t* Bt, int K, int row0, int nrt, int nct, const E& epi, int task0, int ntask_stride, const int tid) {
    const int wid = tid >> 6, lane = tid & 63, fr = lane & 15, fq = lane >> 4;
    LAS f32x4* red = (LAS f32x4*)lds;
    const int nrg = (nrt + RT - 1) / RT, ntasks = nrg * nct, kw = K / 8;
    for (int task = task0; task < ntasks; task += ntask_stride) {
        const int rg = task / nct, ct = task % nct;
        const bf16_t* bp0 = Bt + (size_t)(32 * ct + fr) * K + wid * kw + 8 * fq;
        const bf16_t* bp1 = bp0 + (size_t)16 * K;
        const bf16_t* ap[RT];
#pragma unroll
        for (int r = 0; r < RT; ++r) { const int rt = (RT * rg + r < nrt) ? RT * rg + r : nrt - 1; ap[r] = A + (size_t)(row0 + 16 * rt + fr) * lda + wid * kw + 8 * fq; }
        f32x4 acc[RT][2];
#pragma unroll
        for (int r = 0; r < RT; ++r) { acc[r][0] = (f32x4){0.f, 0.f, 0.f, 0.f}; acc[r][1] = (f32x4){0.f, 0.f, 0.f, 0.f}; }
#pragma unroll 2
        for (int k = 0; k < kw; k += 32) {
            const bf16x8 b0 = *(const bf16x8*)(bp0 + k), b1 = *(const bf16x8*)(bp1 + k);
#pragma unroll
            for (int r = 0; r < RT; ++r) { const bf16x8 av = *(const bf16x8*)(ap[r] + k); acc[r][0] = MFMA16(b0, av, acc[r][0]); acc[r][1] = MFMA16(b1, av, acc[r][1]); }
        }
#pragma unroll
        for (int r = 0; r < RT; ++r) { red[((wid * RT + r) * 2 + 0) * 64 + lane] = acc[r][0]; red[((wid * RT + r) * 2 + 1) * 64 + lane] = acc[r][1]; }
        __syncthreads();
        for (int o = wid; o < RT * 2; o += 8) {
            const int r = o >> 1, n = o & 1;
            if (RT * rg + r < nrt) {
                f32x4 s = {0.f, 0.f, 0.f, 0.f};
#pragma unroll
                for (int w = 0; w < 8; ++w) s += red[((w * RT + r) * 2 + n) * 64 + lane];
                epi.store4(row0 + 16 * (RT * rg + r) + fr, 32 * ct + 16 * n + 4 * fq, s);
            }
        }
        __syncthreads();
    }
}

__device__ __forceinline__ void transpose_item(const float* W, int ldw, int src0, int nblk, bf16_t* WT, int K, int dst0, LAS float* scr, int item, int lane) {
    const int kb = item / nblk, nb = item % nblk, k0 = 64 * kb, n0 = 32 * nb;
    {
        const int kq = lane >> 3, n4 = (lane & 7) * 4;
        f32x4 v[8];
#pragma unroll
        for (int i = 0; i < 8; ++i) v[i] = *(const f32x4*)(W + (size_t)(k0 + 8 * i + kq) * ldw + src0 + n0 + n4);
#pragma unroll
        for (int i = 0; i < 8; ++i) { LAS float* d = scr + (8 * i + kq) * 33 + n4; d[0] = v[i][0]; d[1] = v[i][1]; d[2] = v[i][2]; d[3] = v[i][3]; }
    }
    asm volatile("s_waitcnt lgkmcnt(0)" ::: "memory");
    const int c = lane & 7;
#pragma unroll
    for (int j = 0; j < 4; ++j) { const int n = (lane >> 3) + 8 * j; const LAS float* s = scr + (8 * c) * 33 + n;
        u32x4 o; o.x = cvt_pk_bf16(s[0 * 33], s[1 * 33]); o.y = cvt_pk_bf16(s[2 * 33], s[3 * 33]); o.z = cvt_pk_bf16(s[4 * 33], s[5 * 33]); o.w = cvt_pk_bf16(s[6 * 33], s[7 * 33]);
        *(u32x4*)(WT + (size_t)(dst0 + n0 + n) * K + k0 + 8 * c) = o; }
    asm volatile("s_waitcnt lgkmcnt(0)" ::: "memory");
}
struct TSeg { const float* W; int ldw, src0, n, K; bf16_t* WT; int dst0; };
template <int NS>
__device__ __forceinline__ void transpose_segs(LAS uchar* lds, const TSeg (&segs)[NS], const int tid) {
    const int lane = tid & 63, wave = tid >> 6;
    LAS float* scr = (LAS float*)(lds + wave * 8704);
    const int gw = blockIdx.x * 8 + wave, NGW = gridDim.x * 8;
    int base = 0, next = gw;
#pragma unroll
    for (int s = 0; s < NS; ++s) {
        const int nblk = segs[s].n / 32, items = nblk * (segs[s].K / 64);
        for (; next < base + items; next += NGW) transpose_item(segs[s].W, segs[s].ldw, segs[s].src0, nblk, segs[s].WT, segs[s].K, segs[s].dst0, scr, next - base, lane);
        base += items;
    }
}

__device__ __forceinline__ float wave_sum(float v) {
#pragma unroll
    for (int o = 1; o < 64; o <<= 1) v += __shfl_xor(v, o);
    return v;
}
__device__ __forceinline__ void ln_phase(float* Rm, float* Rt, const float* w, const float* bia, bf16_t* hb, bool final_, const int tid) {
    const int lane = tid & 63, gw = blockIdx.x * 8 + (tid >> 6), NGW = gridDim.x * 8;
    const int nrows = final_ ? MMAIN : MROWS;
    f32x4 wv[4], bv[4];
#pragma unroll
    for (int j = 0; j < 4; ++j) { wv[j] = ((const f32x4*)w)[lane + 64 * j]; bv[j] = ((const f32x4*)bia)[lane + 64 * j]; }
    for (int row = gw; row < nrows; row += NGW) {
        float* rp = row < MMAIN ? Rm + (size_t)row * DM : Rt + (size_t)(row - MMAIN) * DM;
        f32x4 v[4]; float s = 0.f;
#pragma unroll
        for (int j = 0; j < 4; ++j) { v[j] = ((const f32x4*)rp)[lane + 64 * j]; s += (v[j][0] + v[j][1]) + (v[j][2] + v[j][3]); }
        const float mean = wave_sum(s) * (1.f / DM); float s2 = 0.f;
#pragma unroll
        for (int j = 0; j < 4; ++j) { v[j] = v[j] - mean; s2 += (v[j][0] * v[j][0] + v[j][1] * v[j][1]) + (v[j][2] * v[j][2] + v[j][3] * v[j][3]); }
        const float rstd = 1.f / sqrtf(wave_sum(s2) * (1.f / DM) + 1e-5f);
#pragma unroll
        for (int j = 0; j < 4; ++j) {
            const f32x4 y = v[j] * rstd * wv[j] + bv[j];
            ((f32x4*)rp)[lane + 64 * j] = y;
            if (!final_) { u32x2 o = {cvt_pk_bf16(y[0], y[1]), cvt_pk_bf16(y[2], y[3])}; ((u32x2*)(hb + (size_t)row * DM))[lane + 64 * j] = o; }
        }
    }
}
__device__ __forceinline__ void rmsnorm_phase(bf16_t* Y, const float* nw, const int tid) {
    const int lane = tid & 63, gw = blockIdx.x * 8 + (tid >> 6), NGW = gridDim.x * 8;
    const f32x4* wp = (const f32x4*)(nw + 32 * lane);
    for (int row0 = gw; row0 < MROWS; row0 += 2 * NGW) {
        u32x4 raw[2][4];
#pragma unroll
        for (int q = 0; q < 2; ++q) {
            const int row = row0 + q * NGW;
            if (row < MROWS) {
                const u32x4* yp = (const u32x4*)(Y + (size_t)row * 2048 + 32 * lane);
#pragma unroll
                for (int j = 0; j < 4; ++j) raw[q][j] = yp[j];
            }
        }
#pragma unroll
        for (int q = 0; q < 2; ++q) {
            const int row = row0 + q * NGW;
            if (row < MROWS) {
                u32x4* yp = (u32x4*)(Y + (size_t)row * 2048 + 32 * lane);
                float f[32]; float ss = 0.f;
#pragma unroll
                for (int j = 0; j < 4; ++j)
#pragma unroll
                    for (int e = 0; e < 4; ++e) { const unsigned u = raw[q][j][e]; const float lo = bf2f(u & 0xffffu), hi = bf2f(u >> 16); f[8 * j + 2 * e] = lo; f[8 * j + 2 * e + 1] = hi; ss += lo * lo + hi * hi; }
                ss = row16_sum(ss);
                const float rstd = 1.f / sqrtf(ss * (1.f / 512.f) + 1e-6f);
#pragma unroll
                for (int j = 0; j < 4; ++j) { const f32x4 w0 = wp[2 * j], w1 = wp[2 * j + 1];
                    u32x4 o; o.x = cvt_pk_bf16(f[8 * j] * rstd * w0[0], f[8 * j + 1] * rstd * w0[1]); o.y = cvt_pk_bf16(f[8 * j + 2] * rstd * w0[2], f[8 * j + 3] * rstd * w0[3]);
                    o.z = cvt_pk_bf16(f[8 * j + 4] * rstd * w1[0], f[8 * j + 5] * rstd * w1[1]); o.w = cvt_pk_bf16(f[8 * j + 6] * rstd * w1[2], f[8 * j + 7] * rstd * w1[3]);
                    yp[j] = o; }
            }
        }
    }
}

__device__ __forceinline__ void conv8(const bf16_t* P, int ld, int b, int L, int col0, const float* cw, int cwld, int wcol0, const float* cb, float (&out)[8]) {
#pragma unroll
    for (int e = 0; e < 8; ++e) out[e] = cb ? cb[wcol0 + e] : 0.f;
#pragma unroll
    for (int j = 0; j < 4; ++j) {
        const int Lj = L - 3 + j;
        if (Lj >= 48) {
            const u32x4 raw = *(const u32x4*)(P + (size_t)tok_row(b, Lj) * ld + col0);
            const f32x4 w0 = *(const f32x4*)(cw + (size_t)j * cwld + wcol0), w1 = *(const f32x4*)(cw + (size_t)j * cwld + wcol0 + 4);
            out[0] += bf2f(raw[0] & 0xffffu) * w0[0]; out[1] += bf2f(raw[0] >> 16) * w0[1]; out[2] += bf2f(raw[1] & 0xffffu) * w0[2]; out[3] += bf2f(raw[1] >> 16) * w0[3];
            out[4] += bf2f(raw[2] & 0xffffu) * w1[0]; out[5] += bf2f(raw[2] >> 16) * w1[1]; out[6] += bf2f(raw[3] & 0xffffu) * w1[2]; out[7] += bf2f(raw[3] >> 16) * w1[3];
        }
    }
#pragma unroll
    for (int e = 0; e < 8; ++e) out[e] = siluf(out[e]);
}
__device__ __forceinline__ u32x4 pk8(const float (&v)[8]) { u32x4 o = {cvt_pk_bf16(v[0], v[1]), cvt_pk_bf16(v[2], v[3]), cvt_pk_bf16(v[4], v[5]), cvt_pk_bf16(v[6], v[7])}; return o; }

__device__ __forceinline__ int range_row0(int rr) { return rr < 512 ? (rr >> 8) * SEQ + 32 * (rr & 255) : MMAIN; }
__device__ __forceinline__ void halo_save(const bf16_t* P, int ld, int col0, int ncg, bf16_t* HS, const int tid) {
    const int total = 513 * 3 * ncg;
    for (int it = blockIdx.x * NTHREADS + tid; it < total; it += gridDim.x * NTHREADS) {
        const int cgp = it % ncg, k = (it / ncg) % 3, rr = it / (3 * ncg);
        u32x4 v = {0u, 0u, 0u, 0u};
        if (rr < 512) { const int row = ((rr & 255) == 0) ? (MMAIN + 13 + k) : (range_row0(rr) - 3 + k); v = *(const u32x4*)(P + (size_t)row * ld + col0 + 8 * cgp); }
        *(u32x4*)(HS + ((size_t)(rr * 3 + k) * ncg + cgp) * 8) = v;
    }
}
__device__ __forceinline__ void unpack8(const u32x4 raw, float (&o)[8]) {
#pragma unroll
    for (int e = 0; e < 4; ++e) { o[2 * e] = bf2f(raw[e] & 0xffffu); o[2 * e + 1] = bf2f(raw[e] >> 16); }
}
template <int KIND>
__device__ __forceinline__ void conv_inplace(bf16_t* P, int ld, int col0, int ncg, const bf16_t* HS, const Params& p, const int tid) {
    const int total = 513 * ncg;
    for (int it = blockIdx.x * NTHREADS + tid; it < total; it += gridDim.x * NTHREADS) {
        const int cgp = it % ncg, rr = it / ncg;
        const float* cw; int cwld, wc; const float* cb = nullptr; bool norm = false; float scale = 1.f;
        if (KIND == 0) {
            if (cgp < 64) { cw = p.in[I_CONVQ]; cwld = 512; wc = 8 * cgp; norm = true; scale = 0.08838834764831845f; }
            else if (cgp < 128) { cw = p.in[I_CONVK]; cwld = 512; wc = 8 * (cgp - 64); norm = true; }
            else { cw = p.in[I_CONVV]; cwld = 1024; wc = 8 * (cgp - 128); }
        } else { cw = p.in[I_CCONVW]; cwld = 3072; wc = 8 * cgp; cb = p.in[I_CCONVB]; }
        float c0[8], c1[8], c2[8], c3[8], bs[8];
#pragma unroll
        for (int e = 0; e < 8; ++e) { c0[e] = cw[wc + e]; c1[e] = cw[cwld + wc + e]; c2[e] = cw[2 * cwld + wc + e]; c3[e] = cw[3 * cwld + wc + e]; bs[e] = cb ? cb[wc + e] : 0.f; }
        float w0[8], w1[8], w2[8];
        unpack8(*(const u32x4*)(HS + ((size_t)(rr * 3 + 0) * ncg + cgp) * 8), w0);
        unpack8(*(const u32x4*)(HS + ((size_t)(rr * 3 + 1) * ncg + cgp) * 8), w1);
        unpack8(*(const u32x4*)(HS + ((size_t)(rr * 3 + 2) * ncg + cgp) * 8), w2);
        bf16_t* rp = P + (size_t)range_row0(rr) * ld + col0 + 8 * cgp;
        const int len = rr < 512 ? 32 : 16;
#pragma unroll 8
        for (int r = 0; r < len; ++r) {
            float cur[8], o[8];
            unpack8(*(const u32x4*)(rp + (size_t)r * ld), cur);
            float ss = 0.f;
#pragma unroll
            for (int e = 0; e < 8; ++e) { const float a = bs[e] + w0[e] * c0[e] + w1[e] * c1[e] + w2[e] * c2[e] + cur[e] * c3[e]; o[e] = siluf(a); ss += o[e] * o[e]; w0[e] = w1[e]; w1[e] = w2[e]; w2[e] = cur[e]; }
            if (KIND == 0) {
                ss = row16_sum(ss);
                const float sc = norm ? scale / sqrtf(ss + 1e-6f) : 1.f;
#pragma unroll
                for (int e = 0; e < 8; ++e) o[e] *= sc;
            }
            u32x4 ov = {cvt_pk_bf16(o[0], o[1]), cvt_pk_bf16(o[2], o[3]), cvt_pk_bf16(o[4], o[5]), cvt_pk_bf16(o[6], o[7])};
            *(u32x4*)(rp + (size_t)r * ld) = ov;
        }
    }
}
__device__ __forceinline__ void rope_inplace(bf16_t* P, const uchar* ws, const int tid) {
    const int lane = tid & 63, gw = blockIdx.x * 8 + (tid >> 6), NGW = gridDim.x * 8;
    const int isk = lane >> 5, cgp = lane & 7, col = (lane >> 3) * 128 + 8 * cgp;
    const float sc = isk ? 1.f : 0.08838834764831845f;
    for (int row0 = gw; row0 < MROWS; row0 += 2 * NGW) {
        u32x4 r1[2], r2[2]; f32x2 csv[2][8]; bool ok[2];
#pragma unroll
        for (int q = 0; q < 2; ++q) {
            const int row = row0 + q * NGW; ok[q] = row < MROWS;
            if (ok[q]) {
                const int L = row < MMAIN ? 64 + (row & (SEQ - 1)) : 48 + (row - MMAIN);
                const bf16_t* rp = P + (size_t)row * 4096 + col;
                r1[q] = *(const u32x4*)rp; r2[q] = *(const u32x4*)(rp + 64);
                const f32x2* cs = (const f32x2*)(ws + OFF_CS) + (size_t)L * 64 + 8 * cgp;
#pragma unroll
                for (int e = 0; e < 8; ++e) csv[q][e] = cs[e];
            }
        }
#pragma unroll
        for (int q = 0; q < 2; ++q) {
            if (ok[q]) {
                bf16_t* rp = P + (size_t)(row0 + q * NGW) * 4096 + col;
                float x1[8], x2[8], o1[8], o2[8];
                unpack8(r1[q], x1); unpack8(r2[q], x2);
#pragma unroll
                for (int e = 0; e < 8; ++e) { const f32x2 c = csv[q][e]; o1[e] = (x1[e] * c[0] - x2[e] * c[1]) * sc; o2[e] = (x1[e] * c[1] + x2[e] * c[0]) * sc; }
                u32x4 a = {cvt_pk_bf16(o1[0], o1[1]), cvt_pk_bf16(o1[2], o1[3]), cvt_pk_bf16(o1[4], o1[5]), cvt_pk_bf16(o1[6], o1[7])};
                u32x4 bq = {cvt_pk_bf16(o2[0], o2[1]), cvt_pk_bf16(o2[2], o2[3]), cvt_pk_bf16(o2[4], o2[5]), cvt_pk_bf16(o2[6], o2[7])};
                *(u32x4*)rp = a; *(u32x4*)(rp + 64) = bq;
            }
        }
    }
}

constexpr int L_Q = 0, L_K = 17408, L_KT = 34816, L_V = 53248, L_ATT = 87040, L_TINV = 104448, L_FL = 113664;
constexpr int QS = 136  , KTS = 72, VS = 264, ATS = 68, TIS = 72;
constexpr int F_GC = 0, F_EG = 256, F_DL = 512, F_DT = 768, F_BETA = 1024, F_EL = 1088, F_PQ = 1152, F_PK = 2176, F_RED = 3200, F_RST = 4224;

template <int NC>
__device__ __forceinline__ void copy_tile(LAS uchar* lds, int ldsoff, int STR, const bf16_t* P, int ld, int col0, int b, int c, const int tid) {
    constexpr int NCG = NC / 8, RPI = 512 / NCG, NIT = 64 / RPI;
#pragma unroll
    for (int i = 0; i < NIT; ++i) {
        const int t = tid / NCG + RPI * i, cgp = tid % NCG, L = 64 * c + t;
        u32x4 raw = {0u, 0u, 0u, 0u};
        if (L >= 48) raw = *(const u32x4*)(P + (size_t)tok_row(b, L) * ld + col0 + 8 * cgp);
        *(LAS u32x4*)(lds + ldsoff + (t * STR + 8 * cgp) * 2) = raw;
    }
}
template <int NC>
__device__ __forceinline__ void tile_load(u32x4 (&r)[512 / (NC / 8) == 32 ? 2 : 4], const bf16_t* P, int ld, int col0, int b, int c, const int tid) {
    constexpr int NCG = NC / 8, RPI = 512 / NCG, NIT = 64 / RPI;
#pragma unroll
    for (int i = 0; i < NIT; ++i) {
        const int t = tid / NCG + RPI * i, cgp = tid % NCG, L = 64 * c + t;
        r[i] = (u32x4){0u, 0u, 0u, 0u};
        if (L >= 48) r[i] = *(const u32x4*)(P + (size_t)tok_row(b, L) * ld + col0 + 8 * cgp);
    }
}
template <int NC>
__device__ __forceinline__ void tile_store(LAS uchar* lds, int ldsoff, int STR, const u32x4 (&r)[512 / (NC / 8) == 32 ? 2 : 4], const int tid) {
    constexpr int NCG = NC / 8, RPI = 512 / NCG, NIT = 64 / RPI;
#pragma unroll
    for (int i = 0; i < NIT; ++i) { const int t = tid / NCG + RPI * i, cgp = tid % NCG; *(LAS u32x4*)(lds + ldsoff + (t * STR + 8 * cgp) * 2) = r[i]; }
}
__device__ __forceinline__ void make_kT(LAS uchar* lds, const int tid) {
#pragma unroll
    for (int i = 0; i < 2; ++i) {
        const int item = tid + 512 * i, t = item & 63, cgp = item >> 6;
        const u32x4 v = *(const LAS u32x4*)(lds + L_K + (t * QS + 8 * cgp) * 2);
#pragma unroll
        for (int e = 0; e < 4; ++e) {
            *(LAS bf16_t*)(lds + L_KT + ((8 * cgp + 2 * e) * KTS + t) * 2) = (bf16_t)(v[e] & 0xffffu);
            *(LAS bf16_t*)(lds + L_KT + ((8 * cgp + 2 * e + 1) * KTS + t) * 2) = (bf16_t)(v[e] >> 16);
        }
    }
}
__device__ __forceinline__ void gdn_load_gates(LAS uchar* lds, const Params& p, uchar* ws, int b, int h, int c, const int tid) {
    LAS float* FL = (LAS float*)(lds + L_FL);
    if (tid < 64) {
        const int t = tid, L = 64 * c + t; float beta = 0.f, g = 0.f;
        if (L >= 48) {
            const float* sp = (const float*)(ws + OFF_SIDE) + (size_t)tok_row(b, L) * 32;
            beta = 1.f / (1.f + __expf(-sp[h]));
            g = -__expf(p.in[I_ABALOG][h]) * softplusf(sp[4 + h] + p.in[I_ABDTB][h]);
        }
        float v = g;
#pragma unroll
        for (int o = 1; o < 64; o <<= 1) { const float n = __shfl_up(v, o); if (t >= o) v += n; }
        const float gl = __shfl(v, 63);
        FL[F_BETA + t] = beta; FL[F_GC + t] = v; FL[F_EG + t] = __expf(v); FL[F_DL + t] = __expf(gl - v);
        if (t == 63) FL[F_EL] = __expf(gl);
    }
}

__device__ __forceinline__ void tinv_phase(LAS uchar* lds, const Params& p, uchar* ws, const int tid) {
    const int wid = tid >> 6, lane = tid & 63, fr = lane & 15, fq = lane >> 4;
    const bf16_t* P = (const bf16_t*)(ws + OFF_P);
    LAS float* FL = (LAS float*)(lds + L_FL);
    LAS float* AL = (LAS float*)(lds + L_ATT);
    for (int task = blockIdx.x; task < 2 * NCHUNK * 4; task += gridDim.x) {
        const int h = task & 3, c = (task >> 2) % NCHUNK, b = (task >> 2) / NCHUNK;
        __syncthreads();
        gdn_load_gates(lds, p, ws, b, h, c, tid);
        copy_tile<128>(lds, L_K, QS, P, 4096, 2560 + h * 128, b, c, tid);
        __syncthreads();
        {
            const int tt = wid >> 1, st0 = (wid & 1) * 2;
            f32x4 at[2] = {{0.f, 0.f, 0.f, 0.f}, {0.f, 0.f, 0.f, 0.f}};
#pragma unroll
            for (int ks = 0; ks < 4; ++ks) {
                const bf16x8 a = *(const LAS bf16x8*)(lds + L_K + ((16 * tt + fr) * QS + 32 * ks + 8 * fq) * 2);
#pragma unroll
                for (int u = 0; u < 2; ++u) { const bf16x8 bb = *(const LAS bf16x8*)(lds + L_K + ((16 * (st0 + u) + fr) * QS + 32 * ks + 8 * fq) * 2); at[u] = MFMA16(a, bb, at[u]); }
            }
#pragma unroll
            for (int u = 0; u < 2; ++u)
#pragma unroll
                for (int j = 0; j < 4; ++j) {
                    const int t = 16 * tt + 4 * fq + j, s = 16 * (st0 + u) + fr;
                    const float v = (s < t) ? FL[F_BETA + t] * at[u][j] * __expf(FL[F_GC + t] - FL[F_GC + s]) : 0.f;
                    AL[t * ATS + s] = v;
                }
        }
        __syncthreads();
        if (wid == 0) {
            int alb0 = L_ATT; asm volatile("" : "+v"(alb0));
            float x[64];
#pragma unroll
            for (int t = 0; t < 64; ++t) x[t] = 0.f;
#pragma unroll
            for (int t = 0; t < 64; ++t) {
                float a0 = (t == lane) ? 1.f : 0.f, a1 = 0.f, a2 = 0.f, a3 = 0.f;
#pragma unroll
                for (int s4 = 0; s4 * 4 < t; ++s4) {
                    const f32x4 a = *(const LAS f32x4*)(lds + alb0 + (t * ATS + 4 * s4) * 4);
                    a0 -= a[0] * x[4 * s4]; a1 -= a[1] * x[4 * s4 + 1]; a2 -= a[2] * x[4 * s4 + 2]; a3 -= a[3] * x[4 * s4 + 3];
                }
                x[t] = (a0 + a1) + (a2 + a3);
            }
            bf16_t* tp = (bf16_t*)(ws + OFF_TINV) + (size_t)task * 4096;
#pragma unroll
            for (int t = 0; t < 64; ++t) tp[t * 64 + lane] = (bf16_t)f2bf(x[t]);
        }
    }
}

#define LB(name, expr) int name = (expr); asm volatile("" : "+v"(name))
template <int MODE, int PASS, int NT, bool PF_Q = true, bool PF_K = true, bool PF_V = true>
__device__ __forceinline__ void scan_unit(LAS uchar* lds, const Params& p, uchar* ws, int b, int hd, int c0, int c1, const float* Sin, float* Sout, float* Gout, const int tid, const int cfull = 0) {
    constexpr bool GDN = (MODE == 1 || MODE == 3);
    constexpr int NCOL = 128 * NT;
    const int wid = __builtin_amdgcn_readfirstlane(tid >> 6), lane = tid & 63, fr = lane & 15, fq = lane >> 4;
    const bf16_t* P = (const bf16_t*)(ws + OFF_P);
    bf16_t* Y = (bf16_t*)(ws + OFF_Y);
    LAS float* FL = (LAS float*)(lds + L_FL);
    constexpr int LDP = (MODE == 2) ? 3072 : 4096;
    const int qc = MODE == 0 ? hd * 128 : (GDN ? 2048 + hd * 128 : 2560 + (hd >> 1) * 128);
    const int kc = MODE == 0 ? 512 + hd * 128 : (GDN ? 2560 + hd * 128 : 2048 + (hd >> 1) * 128);
    const int vc = MODE == 0 ? 1024 + hd * 256 : (GDN ? 3072 + hd * 256 : hd * 256);
    const int yc = GDN ? 1024 + hd * 256 : hd * 256;
    const int hl = (MODE == 2) ? (wid >> 1) : 0;
    const int dvw = 16 * NT * wid;
    const float lg = (MODE == 0) ? log1pf(-exp2f(-5.f - (float)hd)) : 0.f;
    float Gacc = 0.f;
    f32x4 S[8][NT];
#pragma unroll
    for (int m = 0; m < 8; ++m)
#pragma unroll
        for (int n = 0; n < NT; ++n) {
            if (MODE == 3) {
#pragma unroll
                for (int j = 0; j < 4; ++j) S[m][n][j] = (16 * m + 4 * fq + j == dvw + 16 * n + fr) ? 1.f : 0.f;
            } else if (Sin) {
                S[m][n] = ((const f32x4*)Sin)[((wid * 8 + m) * NT + n) * 64 + lane];
            } else S[m][n] = (f32x4){0.f, 0.f, 0.f, 0.f};
        }

    constexpr bool PFQ = (PASS == 0) && PF_Q, PFK = PF_K, PFV = (MODE != 3) && PF_V;
    u32x4 pq[2], pk[2], pv[4];
    {
        int tl0 = tid; asm volatile("" : "+v"(tl0));
        if (PFQ) tile_load<128>(pq, P, LDP, qc, b, c0, tl0);
        if (PFK) tile_load<128>(pk, P, LDP, kc, b, c0, tl0);
        if (PFV && PASS == 1) tile_load<256>(pv, P, LDP, vc, b, c0, tl0);
    }
    for (int c = c0; c < c1; ++c) {
        __syncthreads();
        int tl = tid; asm volatile("" : "+v"(tl));
        if (PASS == 0) { if (PFQ) tile_store<128>(lds, L_Q, QS, pq, tl); else copy_tile<128>(lds, L_Q, QS, P, LDP, qc, b, c, tl); }
        if (PFK) tile_store<128>(lds, L_K, QS, pk, tl); else copy_tile<128>(lds, L_K, QS, P, LDP, kc, b, c, tl);
        if (MODE != 3) {
            if (PASS == 0 && PFV) { if (c == c0) copy_tile<256>(lds, L_V, VS, P, LDP, vc, b, c, tl); }
            else if (PFV) tile_store<256>(lds, L_V, VS, pv, tl); else copy_tile<256>(lds, L_V, VS, P, LDP, vc, b, c, tl);
        }
        if (PASS == 1 && c + 1 < c1) {
            if (PFQ) tile_load<128>(pq, P, LDP, qc, b, c + 1, tl);
            if (PFK) tile_load<128>(pk, P, LDP, kc, b, c + 1, tl);
            if (PFV) tile_load<256>(pv, P, LDP, vc, b, c + 1, tl);
        }
        if (MODE == 0) {
            if (tl < 64) { const float v = lg * (float)(tl + 1); FL[F_GC + tl] = v; FL[F_EG + tl] = __expf(v); FL[F_DL + tl] = __expf(lg * 64.f - v); if (tl == 63) FL[F_EL] = __expf(lg * 64.f); }
        } else if (GDN) {
            gdn_load_gates(lds, p, ws, b, hd, c, tl);
            {
                const int t = tl >> 3, sg = tl & 7;
                const bf16_t* tp = (const bf16_t*)(ws + OFF_TINV) + (size_t)(((b * NCHUNK + c) << 2) + hd) * 4096;
                *(LAS u32x4*)(lds + L_TINV + (t * TIS + 8 * sg) * 2) = *(const u32x4*)(tp + t * 64 + 8 * sg);
            }
        } else {
            if (tl < 256) {
                const int t = tl & 63, hq = tl >> 6, head = hd * 4 + hq, L = 64 * c + t; float dt = 0.f, g = 0.f;
                if (L >= 48) {
                    const float* sp = (const float*)(ws + OFF_SIDE) + (size_t)tok_row(b, L) * 32;
                    dt = softplusf(sp[head] + p.in[I_CDTB][head]); g = -__expf(p.in[I_CALOG][head]) * dt;
                }
                float v = g;
#pragma unroll
                for (int o = 1; o < 64; o <<= 1) { const float n = __shfl_up(v, o); if (t >= o) v += n; }
                const float gl = __shfl(v, 63);
                FL[F_DT + hq * 64 + t] = dt; FL[F_GC + hq * 64 + t] = v; FL[F_EG + hq * 64 + t] = __expf(v); FL[F_DL + hq * 64 + t] = __expf(gl - v);
                if (t == 63) { FL[F_EL + hq] = __expf(gl); FL[F_EL + 4 + hq] = gl; }
            }
        }
        __syncthreads();
        make_kT(lds, tl);
        const bool full = (PASS == 0) && (c >= cfull);
        if (!full) __syncthreads();
        if (MODE == 2 && PASS == 1) Gacc += FL[F_EL + 4 + hl];
        if (PASS == 0 && full) {
            LB(qnb, L_Q + ((16 * (wid >> 1) + fr) * QS + 8 * fq) * 2); LB(knb, L_K + ((32 * (wid & 1) + fr) * QS + 8 * fq) * 2);
            LB(awb, L_ATT + ((16 * (wid >> 1) + 4 * fq) * ATS + 32 * (wid & 1) + fr) * 4);
            f32x4 at[2] = {{0.f, 0.f, 0.f, 0.f}, {0.f, 0.f, 0.f, 0.f}};
#pragma unroll
            for (int ks = 0; ks < 4; ++ks) {
                const bf16x8 a = *(const LAS bf16x8*)(lds + qnb + 64 * ks);
#pragma unroll
                for (int u = 0; u < 2; ++u) { const bf16x8 bb = *(const LAS bf16x8*)(lds + knb + u * (16 * QS * 2) + 64 * ks); at[u] = MFMA16(a, bb, at[u]); }
            }
#pragma unroll
            for (int u = 0; u < 2; ++u)
#pragma unroll
                for (int j = 0; j < 4; ++j) *(LAS float*)(lds + awb + (j * ATS + 16 * u) * 4) = at[u][j];
        }
        __builtin_amdgcn_sched_barrier(0);
        f32x4 Vn[4][NT];
        if (GDN) {
            LB(kpb, L_K + (fr * QS + 4 * fq) * 2); LB(flq, L_FL + (hl * 64 + 4 * fq) * 4); LB(vb, L_V + ((4 * fq) * VS + dvw + fr) * 2); LB(tib, L_TINV + (fr * TIS + 4 * fq) * 2);
            f32x4 R_[4][NT];
#pragma unroll
            for (int st = 0; st < 4; ++st)
#pragma unroll
                for (int n = 0; n < NT; ++n) R_[st][n] = (f32x4){0.f, 0.f, 0.f, 0.f};
#pragma unroll
            for (int ks = 0; ks < 4; ++ks) {
                bf16x8 bfr[NT];
#pragma unroll
                for (int n = 0; n < NT; ++n) bfr[n] = pack8(S[2 * ks][n], S[2 * ks + 1][n]);
#pragma unroll
                for (int st = 0; st < 4; ++st) {
                    const LAS uchar* ap = lds + kpb + (16 * st * QS + 32 * ks) * 2;
                    const bf16x8 a = mk8(*(const LAS u32x2*)ap, *(const LAS u32x2*)(ap + 32));
#pragma unroll
                    for (int n = 0; n < NT; ++n) R_[st][n] = MFMA16(a, bfr[n], R_[st][n]);
                }
            }
#pragma unroll
            for (int st = 0; st < 4; ++st) {
                const f32x4 be = *(const LAS f32x4*)(lds + flq + (F_BETA + 16 * st) * 4), eg = *(const LAS f32x4*)(lds + flq + (F_EG + 16 * st) * 4);
#pragma unroll
                for (int n = 0; n < NT; ++n)
#pragma unroll
                    for (int j = 0; j < 4; ++j) {
                        float v = 0.f;
                        if (MODE == 1) v = bf2f(*(const LAS bf16_t*)(lds + vb + ((16 * st + j) * VS + 16 * n) * 2));
                        R_[st][n][j] = be[j] * (v - eg[j] * R_[st][n][j]);
                    }
            }
#pragma unroll
            for (int tt = 0; tt < 4; ++tt)
#pragma unroll
                for (int n = 0; n < NT; ++n) Vn[tt][n] = (f32x4){0.f, 0.f, 0.f, 0.f};
#pragma unroll
            for (int ks = 0; ks < 2; ++ks) {
                bf16x8 bfr[NT];
#pragma unroll
                for (int n = 0; n < NT; ++n) bfr[n] = pack8(R_[2 * ks][n], R_[2 * ks + 1][n]);
#pragma unroll
                for (int tt = 0; tt < 4; ++tt) {
                    const LAS uchar* ap = lds + tib + (16 * tt * TIS + 32 * ks) * 2;
                    const bf16x8 a = mk8(*(const LAS u32x2*)ap, *(const LAS u32x2*)(ap + 32));
#pragma unroll
                    for (int n = 0; n < NT; ++n) Vn[tt][n] = MFMA16(a, bfr[n], Vn[tt][n]);
                }
            }
        } else {
            LB(flq, L_FL + (hl * 64 + 4 * fq) * 4); LB(vb, L_V + ((4 * fq) * VS + dvw + fr) * 2);
#pragma unroll
            for (int st = 0; st < 4; ++st) {
                f32x4 dtv = {1.f, 1.f, 1.f, 1.f};
                if (MODE == 2) dtv = *(const LAS f32x4*)(lds + flq + (F_DT + 16 * st) * 4);
#pragma unroll
                for (int n = 0; n < NT; ++n)
#pragma unroll
                    for (int j = 0; j < 4; ++j)
                        Vn[st][n][j] = bf2f(*(const LAS bf16_t*)(lds + vb + ((16 * st + j) * VS + 16 * n) * 2)) * dtv[j];
            }
        }
        __builtin_amdgcn_sched_barrier(0);
        f32x4 O[4][NT];
        if (PASS == 0 && full) {
            {
                LB(qpb, L_Q + (fr * QS + 4 * fq) * 2); LB(flq, L_FL + (hl * 64 + 4 * fq) * 4);
#pragma unroll
                for (int tt = 0; tt < 4; ++tt)
#pragma unroll
                    for (int n = 0; n < NT; ++n) O[tt][n] = (f32x4){0.f, 0.f, 0.f, 0.f};
#pragma unroll
                for (int ks = 0; ks < 4; ++ks) {
                    bf16x8 bfr[NT];
#pragma unroll
                    for (int n = 0; n < NT; ++n) bfr[n] = pack8(S[2 * ks][n], S[2 * ks + 1][n]);
#pragma unroll
                    for (int tt = 0; tt < 4; ++tt) {
                        const LAS uchar* ap = lds + qpb + (16 * tt * QS + 32 * ks) * 2;
                        const bf16x8 a = mk8(*(const LAS u32x2*)ap, *(const LAS u32x2*)(ap + 32));
#pragma unroll
                        for (int n = 0; n < NT; ++n) O[tt][n] = MFMA16(a, bfr[n], O[tt][n]);
                    }
                }
#pragma unroll
                for (int tt = 0; tt < 4; ++tt) {
                    const f32x4 eg = *(const LAS f32x4*)(lds + flq + (F_EG + 16 * tt) * 4);
#pragma unroll
                    for (int n = 0; n < NT; ++n) O[tt][n] = O[tt][n] * eg;
                }
            }
            __syncthreads();
            u32x4 gate[4];
            const bool wr_ok = !(c == 0 && b == 1);
            const int rowbase = (c == 0) ? (MMAIN - 48) : (b * SEQ + (c - 1) * 64);
#pragma unroll
            for (int i = 0; i < 4; ++i) {
                const int t = (tid >> 5) + 16 * i;
                gate[i] = (u32x4){0u, 0u, 0u, 0u};
                if (wr_ok && (c > 0 || t >= 48)) gate[i] = *(const u32x4*)(Y + (size_t)(rowbase + t) * 2048 + yc + 8 * (tid & 31));
            }
            if (PFV && c + 1 < c1) { int tl3 = tid; asm volatile("" : "+v"(tl3)); tile_load<256>(pv, P, LDP, vc, b, c + 1, tl3); }
            {
                LB(alb, L_ATT + (fr * ATS + 4 * fq) * 4); LB(flq, L_FL + (hl * 64 + 4 * fq) * 4); LB(flr, L_FL + (hl * 64 + fr) * 4);
#pragma unroll
                for (int ks = 0; ks < 2; ++ks) {
                    bf16x8 bfr[NT];
#pragma unroll
                    for (int n = 0; n < NT; ++n) bfr[n] = pack8(Vn[2 * ks][n], Vn[2 * ks + 1][n]);
                    const int s_lo = 32 * ks + 4 * fq, s_hi = s_lo + 16;
                    const f32x4 gs_lo = *(const LAS f32x4*)(lds + flq + (F_GC + 32 * ks) * 4), gs_hi = *(const LAS f32x4*)(lds + flq + (F_GC + 32 * ks + 16) * 4);
#pragma unroll
                    for (int tt = 0; tt < 4; ++tt) {
                        const int t = 16 * tt + fr; const float gt = *(const LAS float*)(lds + flr + (F_GC + 16 * tt) * 4);
                        f32x4 a_lo = *(const LAS f32x4*)(lds + alb + (16 * tt * ATS + 32 * ks) * 4), a_hi = *(const LAS f32x4*)(lds + alb + (16 * tt * ATS + 32 * ks + 16) * 4);
#pragma unroll
                        for (int j = 0; j < 4; ++j) {
                            a_lo[j] = (s_lo + j <= t) ? a_lo[j] * __expf(gt - gs_lo[j]) : 0.f;
                            a_hi[j] = (s_hi + j <= t) ? a_hi[j] * __expf(gt - gs_hi[j]) : 0.f;
                        }
                        const bf16x8 a = pack8(a_lo, a_hi);
#pragma unroll
                        for (int n = 0; n < NT; ++n) O[tt][n] = MFMA16(a, bfr[n], O[tt][n]);
                    }
                }
            }
#pragma unroll
            for (int i = 0; i < 4; ++i) *(LAS u32x4*)(lds + (((tid >> 5) + 16 * i) * VS + 8 * (tid & 31)) * 2) = gate[i];
        }
        __builtin_amdgcn_sched_barrier(0);
        {
            LB(ktb, L_KT + (fr * KTS + 4 * fq) * 2); LB(flq, L_FL + (hl * 64 + 4 * fq) * 4);
            const float el = FL[F_EL + hl];
#pragma unroll
            for (int m = 0; m < 8; ++m)
#pragma unroll
                for (int n = 0; n < NT; ++n) S[m][n] = S[m][n] * el;
#pragma unroll
            for (int ks = 0; ks < 2; ++ks) {
                const f32x4 d0 = *(const LAS f32x4*)(lds + flq + (F_DL + 32 * ks) * 4), d1 = *(const LAS f32x4*)(lds + flq + (F_DL + 32 * ks + 16) * 4);
                bf16x8 bfr[NT];
#pragma unroll
                for (int n = 0; n < NT; ++n) bfr[n] = pack8(Vn[2 * ks][n] * d0, Vn[2 * ks + 1][n] * d1);
#pragma unroll
                for (int m = 0; m < 8; ++m) {
                    const LAS uchar* ap = lds + ktb + (16 * m * KTS + 32 * ks) * 2;
                    const bf16x8 a = mk8(*(const LAS u32x2*)ap, *(const LAS u32x2*)(ap + 32));
#pragma unroll
                    for (int n = 0; n < NT; ++n) S[m][n] = MFMA16(a, bfr[n], S[m][n]);
                }
            }
        }
        __builtin_amdgcn_sched_barrier(0);
        if (PASS == 0 && c + 1 < c1) {
            int tl2 = tid; asm volatile("" : "+v"(tl2));
            if (PFQ) tile_load<128>(pq, P, LDP, qc, b, c + 1, tl2);
            if (PFK) tile_load<128>(pk, P, LDP, kc, b, c + 1, tl2);
        }
        if (PASS == 0 && full) {
            LB(rdb, L_FL + (F_RED + (4 * fq * 8 + wid) * 2) * 4); LB(rsb, L_FL + (F_RST + 4 * fq * 2) * 4); LB(vb2, L_V + ((4 * fq) * VS + dvw + fr) * 2);
            LB(stb, ((4 * fq) * VS + dvw + fr) * 2);
            if (MODE != 2) {
#pragma unroll
                for (int tt = 0; tt < 4; ++tt)
#pragma unroll
                    for (int j = 0; j < 4; ++j) {
                        float s1 = 0.f, s2 = 0.f;
#pragma unroll
                        for (int n = 0; n < NT; ++n) { s1 += O[tt][n][j]; s2 += O[tt][n][j] * O[tt][n][j]; }
                        s1 = row16_sum(s1); s2 = row16_sum(s2);
                        if (fr == 0) *(LAS f32x2*)(lds + rdb + ((16 * tt + j) * 8) * 8) = (f32x2){s1, s2};
                    }
                __syncthreads();
                if (tid < 64) {
                    float s1 = 0.f, s2 = 0.f;
#pragma unroll
                    for (int w = 0; w < 8; ++w) { s1 += FL[F_RED + (tid * 8 + w) * 2]; s2 += FL[F_RED + (tid * 8 + w) * 2 + 1]; }
                    float mean, rstd;
                    if (MODE == 0) { mean = s1 * (1.f / 256.f); const float var = fmaxf(s2 * (1.f / 256.f) - mean * mean, 0.f); rstd = 1.f / sqrtf(var + 1e-5f); }
                    else { mean = 0.f; rstd = 1.f / sqrtf(s2 * (1.f / 256.f) + 1e-6f); }
                    FL[F_RST + 2 * tid] = mean; FL[F_RST + 2 * tid + 1] = rstd;
                }
            }
            if (MODE == 2) {
                const float dsk = p.in[I_CD][hd * 4 + hl];
#pragma unroll
                for (int n = 0; n < NT; ++n)
#pragma unroll
                    for (int tt = 0; tt < 4; ++tt)
#pragma unroll
                        for (int j = 0; j < 4; ++j) O[tt][n][j] += bf2f(*(const LAS bf16_t*)(lds + vb2 + ((16 * tt + j) * VS + 16 * n) * 2)) * dsk;
            }
            __syncthreads();
            if (PFV && c + 1 < c1) { int tl4 = tid; asm volatile("" : "+v"(tl4)); tile_store<256>(lds, L_V, VS, pv, tl4); }
            {
                const float* nw = (MODE == 0) ? p.in[I_RETGN] + hd * 256 : p.in[I_GDNNW];
#pragma unroll
                for (int n = 0; n < NT; ++n) {
                    float wgt = 1.f;
                    if (MODE == 0 || MODE == 1) wgt = nw[dvw + 16 * n + fr];
                    if (MODE == 2) wgt = p.in[I_CD][hd * 4 + hl];
#pragma unroll
                    for (int tt = 0; tt < 4; ++tt) {
#pragma unroll
                        for (int j = 0; j < 4; ++j) {
                            float val;
                            if (MODE == 2) val = O[tt][n][j];
                            else { const f32x2 ms = *(const LAS f32x2*)(lds + rsb + (16 * tt + j) * 8); val = (O[tt][n][j] - ms[0]) * ms[1] * wgt; }
                            LAS bf16_t* sp = (LAS bf16_t*)(lds + stb + ((16 * tt + j) * VS + 16 * n) * 2);
                            *sp = (bf16_t)f2bf(val * bf2f(*sp));
                        }
                    }
                }
            }
            __syncthreads();
            if (!(c == 0 && b == 1)) {
                const int rowbase = (c == 0) ? (MMAIN - 48) : (b * SEQ + (c - 1) * 64);
#pragma unroll
                for (int i = 0; i < 4; ++i) {
                    const int t = (tid >> 5) + 16 * i;
                    if (c > 0 || t >= 48) *(u32x4*)(Y + (size_t)(rowbase + t) * 2048 + yc + 8 * (tid & 31)) = *(const LAS u32x4*)(lds + (t * VS + 8 * (tid & 31)) * 2);
                }
            }
        }
    }
    if (Sout) {
#pragma unroll
        for (int m = 0; m < 8; ++m)
#pragma unroll
            for (int n = 0; n < NT; ++n)
            {
                if (NT == 2) ((f32x4*)Sout)[((wid * 8 + m) * NT + n) * 64 + lane] = S[m][n];
                else {
#pragma unroll
                    for (int j = 0; j < 4; ++j) Sout[(size_t)(16 * m + 4 * fq + j) * NCOL + dvw + 16 * n + fr] = S[m][n][j];
                }
            }
    }
    if (MODE == 2 && PASS == 1 && Gout) { if (lane == 0 && (wid & 1) == 0) Gout[hl] = Gacc; }
}

constexpr int SEG0 = 12, NSEG0 = 11;
constexpr int SEG1 = 9, NSEG1 = 15;
__device__ __forceinline__ void gdn_chain(LAS uchar* lds, float* Q, const float* Pm, const int half, const int tid) {
    const int wid = __builtin_amdgcn_readfirstlane(tid >> 6), lane = tid & 63, fr = lane & 15, fq = lane >> 4, dvw = half * 128 + 16 * wid;
    f32x4 S[8];
#pragma unroll
    for (int m = 0; m < 8; ++m) S[m] = (f32x4){0.f, 0.f, 0.f, 0.f};
    f32x4 pp[8];
    {
        int tl0 = tid; asm volatile("" : "+v"(tl0));
#pragma unroll
        for (int i = 0; i < 8; ++i) { const int idx = tl0 + 512 * i; pp[i] = *(const f32x4*)(Pm + (idx >> 5) * 128 + 4 * (idx & 31)); }
    }
#pragma unroll 1
    for (int j = 0; j < NSEG0 - 1; ++j) {
        __syncthreads();
        int tl = tid; asm volatile("" : "+v"(tl));
#pragma unroll
        for (int i = 0; i < 8; ++i) {
            const int idx = tl + 512 * i, row = idx >> 5, c4 = idx & 31;
            u32x2 o = {cvt_pk_bf16(pp[i][0], pp[i][1]), cvt_pk_bf16(pp[i][2], pp[i][3])};
            *(LAS u32x2*)(lds + (row * QS + 4 * c4) * 2) = o;
        }
        if (j + 1 < NSEG0 - 1) {
            const float* Pn = Pm + (size_t)(j + 1) * 16384;
#pragma unroll
            for (int i = 0; i < 8; ++i) { const int idx = tl + 512 * i; pp[i] = *(const f32x4*)(Pn + (idx >> 5) * 128 + 4 * (idx & 31)); }
        }
        f32x4* Qj = (f32x4*)(Q + (size_t)j * 32768) + (((half * 4 + (wid >> 1)) * 8) * 2 + (wid & 1)) * 64 + lane;
        f32x4 Qv[8];
#pragma unroll
        for (int m = 0; m < 8; ++m)
            Qv[m] = Qj[m * 128];
        __syncthreads();
        f32x4 Sn[8];
#pragma unroll
        for (int m = 0; m < 8; ++m) Sn[m] = (f32x4){0.f, 0.f, 0.f, 0.f};
        LB(pb, (fr * QS + 4 * fq) * 2);
#pragma unroll
        for (int ks = 0; ks < 4; ++ks) {
            const bf16x8 b0 = pack8(S[2 * ks], S[2 * ks + 1]);
#pragma unroll
            for (int m = 0; m < 8; ++m) {
                const LAS uchar* ap = lds + pb + (16 * m * QS + 32 * ks) * 2;
                const bf16x8 a = mk8(*(const LAS u32x2*)ap, *(const LAS u32x2*)(ap + 32));
                Sn[m] = MFMA16(a, b0, Sn[m]);
            }
        }
#pragma unroll
        for (int m = 0; m < 8; ++m)
        { const f32x4 v = Sn[m] + Qv[m]; S[m] = v; Qj[m * 128] = v; }
    }
}

#define XB_TMO      128
#define XB_XCNT(j)  (256  + 64 * (j))
#define XB_XSUB(j)  (1280 + 64 * (j))
#define XB_XGEN(j)  (2304 + 64 * (j))
#define XB_TOP      3328
#define XB_TOPGEN   3392
#define XCD_BAR_WORDS 3456
#define XB_SPIN_CAP (1u << 18)

__device__ __forceinline__ unsigned xb_ld(unsigned* p)              { return __hip_atomic_load(p, __ATOMIC_RELAXED, __HIP_MEMORY_SCOPE_AGENT); }
__device__ __forceinline__ unsigned xb_add(unsigned* p, unsigned v) { return __hip_atomic_fetch_add(p, v, __ATOMIC_RELAXED, __HIP_MEMORY_SCOPE_AGENT); }
__device__ __forceinline__ unsigned xb_xcc_id() { return (unsigned)__builtin_amdgcn_s_getreg((3 << 11) | 20) & 0xFu; }
#define XB_SPIN(cond, bar) do { unsigned _sp = 0; while (cond) { __builtin_amdgcn_s_sleep(1); \
    if ((++_sp & 255u) == 0u) { if (xb_ld(&(bar)[XB_TMO])) break; if (_sp > XB_SPIN_CAP) { atomicAdd(&(bar)[XB_TMO], 1u); break; } } } } while (0)

struct XcdBarrier {
    unsigned* bar; unsigned x;
    volatile LAS unsigned* st;
};

__device__ __forceinline__ XcdBarrier xcd_barrier_post(unsigned* bar, volatile LAS unsigned* st) {
    XcdBarrier b; b.bar = bar; b.x = xb_xcc_id(); b.st = st;
    if (threadIdx.x == 0) (void)xb_add(&bar[XB_XCNT(b.x)], 1u);
    return b;
}
__device__ __forceinline__ void xcd_barrier_complete(unsigned* bar, unsigned x, unsigned& nloc, unsigned& nx) {
    const unsigned G = gridDim.x * gridDim.y * gridDim.z;
    unsigned sum, cnt, mine, sp = 0u;
    for (;;) {
        sum = 0u; cnt = 0u; mine = 0u;
#pragma unroll
        for (unsigned j = 0; j < 16; ++j) { const unsigned c = xb_ld(&bar[XB_XCNT(j)]); sum += c; cnt += (c > 0u) ? 1u : 0u; mine = (j == x) ? c : mine; }
        if (sum == G) break;
        __builtin_amdgcn_s_sleep(1);
        if ((++sp & 255u) == 0u) { if (xb_ld(&bar[XB_TMO])) break; if (sp > XB_SPIN_CAP) { atomicAdd(&bar[XB_TMO], 1u); break; } }
    }
    nloc = mine > 0u ? mine : 1u; nx = cnt > 0u ? cnt : 1u;
}

__device__ __forceinline__ void xcd_barrier(const XcdBarrier& b) {
    asm volatile("s_waitcnt vmcnt(0)" ::: "memory");
    __syncthreads();
    if (threadIdx.x == 0) {
        unsigned* bar = b.bar;
        __builtin_amdgcn_s_waitcnt(0);
        unsigned nloc = b.st[0], nx = b.st[1];
        if (nloc == 0u) { xcd_barrier_complete(bar, b.x, nloc, nx); b.st[0] = nloc; b.st[1] = nx; }
        const unsigned old = xb_add(&bar[XB_XSUB(b.x)], 1u);
        const unsigned gen = old / nloc;
        if (old + 1u == (gen + 1u) * nloc) {
            __builtin_amdgcn_fence(__ATOMIC_RELEASE, "agent");
            asm volatile("s_waitcnt vmcnt(0)" ::: "memory");
            const unsigned og = xb_add(&bar[XB_TOP], 1u);
            const unsigned tg = og / nx;
            if (og + 1u == (tg + 1u) * nx) xb_add(&bar[XB_TOPGEN], 1u);
            else XB_SPIN(xb_ld(&bar[XB_TOPGEN]) == tg, bar);
            __builtin_amdgcn_fence(__ATOMIC_ACQUIRE, "agent");
            xb_add(&bar[XB_XGEN(b.x)], 1u);
            asm volatile("s_waitcnt vmcnt(0)" ::: "memory");
        } else {
            XB_SPIN(xb_ld(&bar[XB_XGEN(b.x)]) == gen, bar);
            __builtin_amdgcn_fence(__ATOMIC_ACQUIRE, "agent");
            asm volatile("s_waitcnt vmcnt(0)" ::: "memory");
        }
    }
    __syncthreads();
}


template <int SRC, bool WRITE_HB> struct EpiLN {
    static constexpr bool AFTER_DRAIN = true;
    float* Rm; const float* x; const float* lnw; const float* lnb; bf16_t* hb; f32x2* stats;
    __device__ __forceinline__ void fused(f32x4 (&acc)[2][2][4][2], const pg8::Unit& u, int wr, int wc, int fr, int fq, LAS uchar* lds, const int tid, const XcdBarrier& xbar) const {
        LAS f32x2* PT = (LAS f32x2*)lds;
        LAS f32x2* ST = (LAS f32x2*)(lds + 8192);
        const int row0 = u.pm * 256 + wr * 64 + fr, colt = u.pn * 256 + wc * 32 + 8 * fq;
#pragma unroll
        for (int ai = 0; ai < 2; ++ai) {
            f32x4 hv[4][2][2];
#pragma unroll
            for (int m = 0; m < 4; ++m) {
                const float* hp = (SRC == 0 ? x : Rm) + (size_t)(row0 + ai * 128 + m * 16) * DM + colt;
#pragma unroll
                for (int bj = 0; bj < 2; ++bj) { hv[m][bj][0] = *(const f32x4*)(hp + bj * 128); hv[m][bj][1] = *(const f32x4*)(hp + bj * 128 + 4); }
            }
#pragma unroll
            for (int m = 0; m < 4; ++m) {
                float s1 = 0.f, s2 = 0.f;
#pragma unroll
                for (int bj = 0; bj < 2; ++bj) {
                    const f32x4 v0 = hv[m][bj][0] * DN_ALPHA + acc[ai][bj][m][0], v1 = hv[m][bj][1] * DN_ALPHA + acc[ai][bj][m][1];
                    acc[ai][bj][m][0] = v0; acc[ai][bj][m][1] = v1;
#pragma unroll
                    for (int e = 0; e < 4; ++e) { s1 += v0[e] + v1[e]; s2 += v0[e] * v0[e] + v1[e] * v1[e]; }
                }
                s1 += __shfl_xor(s1, 16); s1 += __shfl_xor(s1, 32); s2 += __shfl_xor(s2, 16); s2 += __shfl_xor(s2, 32);
                if (fq == 0) PT[(ai * 128 + wr * 64 + m * 16 + fr) * 4 + wc] = (f32x2){s1, s2};
            }
            __builtin_amdgcn_sched_barrier(0);
        }
        __syncthreads();
        if (tid < 256) {
            const f32x2 a = PT[tid * 4 + 0], b = PT[tid * 4 + 1], c = PT[tid * 4 + 2], d = PT[tid * 4 + 3];
            stats[(size_t)(u.pm * 256 + tid) * 4 + u.pn] = (f32x2){(a[0] + b[0]) + (c[0] + d[0]), (a[1] + b[1]) + (c[1] + d[1])};
        }
        xcd_barrier(xbar);
        if (tid < 256) {
            const f32x2* sp = stats + (size_t)(u.pm * 256 + tid) * 4;
            const f32x2 a = sp[0], b = sp[1], c = sp[2], d = sp[3];
            const float mean = ((a[0] + b[0]) + (c[0] + d[0])) * (1.f / DM);
            const float var = fmaxf(((a[1] + b[1]) + (c[1] + d[1])) * (1.f / DM) - mean * mean, 0.f);
            ST[tid] = (f32x2){mean, 1.f / sqrtf(var + 1e-5f)};
        }
        __syncthreads();
        f32x4 wv[2][2], bv[2][2];
#pragma unroll
        for (int bj = 0; bj < 2; ++bj)
#pragma unroll
            for (int n = 0; n < 2; ++n) { wv[bj][n] = *(const f32x4*)(lnw + colt + bj * 128 + 4 * n); bv[bj][n] = *(const f32x4*)(lnb + colt + bj * 128 + 4 * n); }
#pragma unroll
        for (int ai = 0; ai < 2; ++ai)
#pragma unroll
            for (int m = 0; m < 4; ++m) {
                const int rl = ai * 128 + wr * 64 + m * 16 + fr, row = u.pm * 256 + rl;
                const f32x2 ms = ST[rl];
                float* rp = Rm + (size_t)row * DM + colt;
#pragma unroll
                for (int bj = 0; bj < 2; ++bj) {
                    const f32x4 y0 = (acc[ai][bj][m][0] - ms[0]) * ms[1] * wv[bj][0] + bv[bj][0], y1 = (acc[ai][bj][m][1] - ms[0]) * ms[1] * wv[bj][1] + bv[bj][1];
                    *(f32x4*)(rp + bj * 128) = y0; *(f32x4*)(rp + bj * 128 + 4) = y1;
                    if (WRITE_HB) { u32x4 w = {cvt_pk_bf16(y0[0], y0[1]), cvt_pk_bf16(y0[2], y0[3]), cvt_pk_bf16(y1[0], y1[1]), cvt_pk_bf16(y1[2], y1[3])}; *(u32x4*)(hb + (size_t)row * DM + colt + bj * 128) = w; }
                }
                __builtin_amdgcn_sched_barrier(0);
            }
    }
};
__device__ __forceinline__ void ln_tail_row(float* rp, const float* w, const float* bia, bf16_t* hbrow, const int lane) {
    f32x4 v[4]; float s = 0.f;
#pragma unroll
    for (int j = 0; j < 4; ++j) { v[j] = ((const f32x4*)rp)[lane + 64 * j]; s += (v[j][0] + v[j][1]) + (v[j][2] + v[j][3]); }
    const float mean = wave_sum(s) * (1.f / DM); float s2 = 0.f;
#pragma unroll
    for (int j = 0; j < 4; ++j) { v[j] = v[j] - mean; s2 += (v[j][0] * v[j][0] + v[j][1] * v[j][1]) + (v[j][2] * v[j][2] + v[j][3] * v[j][3]); }
    const float rstd = 1.f / sqrtf(wave_sum(s2) * (1.f / DM) + 1e-5f);
#pragma unroll
    for (int j = 0; j < 4; ++j) {
        const f32x4 y = v[j] * rstd * ((const f32x4*)w)[lane + 64 * j] + ((const f32x4*)bia)[lane + 64 * j];
        ((f32x4*)rp)[lane + 64 * j] = y;
        u32x2 o = {cvt_pk_bf16(y[0], y[1]), cvt_pk_bf16(y[2], y[3])}; ((u32x2*)hbrow)[lane + 64 * j] = o;
    }
}

__global__ void __launch_bounds__(NTHREADS, 2) mega_fwd(Params p) {
    extern __shared__ __attribute__((aligned(16))) uchar lds_raw[];
    LAS uchar* lds = (LAS uchar*)lds_raw;
    cg::grid_group grid = cg::this_grid();
    const int bid = blockIdx.x, nb = gridDim.x;
    const int wave0 = __builtin_amdgcn_readfirstlane((int)threadIdx.x >> 6);
    volatile LAS unsigned* MISC = (volatile LAS unsigned*)(lds + 131072);
    if (threadIdx.x < 2) MISC[threadIdx.x] = 0u;
    __syncthreads();
    const XcdBarrier xb = xcd_barrier_post((unsigned*)(p.ws + OFF_BAR), MISC);
#define GSYNC() xcd_barrier(xb)
#define PHASE_VARS \
    int tid; asm volatile("v_mbcnt_lo_u32_b32 %0, -1, 0\n\tv_mbcnt_hi_u32_b32 %0, -1, %0" : "=v"(tid)); tid += wave0 * 64; \
    uchar* ws = p.ws; asm volatile("" : "+s"(ws)); int nbl = nb; asm volatile("" : "+s"(nbl)); (void)nbl; \
    float* Rm = p.out; asm volatile("" : "+s"(Rm)); \
    bf16_t* HB = (bf16_t*)(ws + OFF_HB); bf16_t* Yb = (bf16_t*)(ws + OFF_Y); bf16_t* Pb = (bf16_t*)(ws + OFF_P); \
    bf16_t* WA = (bf16_t*)(ws + OFF_WA); bf16_t* WO = (bf16_t*)(ws + OFF_WOUT); bf16_t* WSM = (bf16_t*)(ws + OFF_WSM); \
    bf16_t* W1t = (bf16_t*)(ws + OFF_TINV); bf16_t* W2t = (bf16_t*)(ws + OFF_WA); f32x2* lnstats = (f32x2*)(ws + OFF_SIDE); \
    float* Rt = (float*)(ws + OFF_RT); float* side = (float*)(ws + OFF_SIDE); \
    (void)HB; (void)Yb; (void)Pb; (void)WA; (void)WO; (void)WSM; (void)W1t; (void)W2t; (void)lnstats; (void)Rt; (void)side; (void)Rm;
    const int lo = p.ph_lo, hi = p.ph_hi;
#define IN(k) (lo <= (k) && (k) < hi)
#define REPEAT(n) for (int rep_ = 0; rep_ < (n); ++rep_, (rep_ < (n) ? GSYNC() : (void)0))
#define SEAM(k) do { if (IN(k) && IN((k) + 1)) GSYNC(); } while (0)
    if (lo > hi) grid.sync();

    if (IN(0)) REPEAT(REP0) {
        PHASE_VARS
        {
            const int lane = tid & 63, gw = bid * 8 + (tid >> 6), NGW = nb * 8;
            for (int row0 = gw; row0 < MROWS; row0 += 4 * NGW) {
                f32x4 v[4][4];
#pragma unroll
                for (int q = 0; q < 4; ++q) {
                    const int row = row0 + q * NGW;
                    if (row < MROWS) {
                        const float* xp = row < MMAIN ? p.in[I_X] + (size_t)row * DM : p.in[I_META] + (size_t)(row - MMAIN) * DM;
#pragma unroll
                        for (int j = 0; j < 4; ++j) v[q][j] = ((const f32x4*)xp)[lane + 64 * j];
                    }
                }
#pragma unroll
                for (int q = 0; q < 4; ++q) {
                    const int row = row0 + q * NGW;
                    if (row < MROWS) {
#pragma unroll
                        for (int j = 0; j < 4; ++j) { u32x2 o = {cvt_pk_bf16(v[q][j][0], v[q][j][1]), cvt_pk_bf16(v[q][j][2], v[q][j][3])}; ((u32x2*)(HB + (size_t)row * DM))[lane + 64 * j] = o; }
                    }
                }
            }
        }
        {
            const float* w = p.in[I_ABWIN];
            const TSeg segs[5] = {{w, 6152, 0, 2048, 1024, WA, 0}, {w, 6152, 3072, 2048, 1024, WA, 2048}, {w, 6152, 2048, 1024, 1024, WA, 4096}, {w, 6152, 5128, 1024, 1024, WA, 5120},
                                  {p.in[I_ABWOUT], 1024, 0, 1024, 2048, WO, 0}};
            transpose_segs<5>(lds, segs, tid);
        }
        for (int i = bid * NTHREADS + tid; i < 32 * 1024; i += nbl * NTHREADS) {
            const int r = i >> 10, k = i & 1023;
            WSM[i] = r < 8 ? (bf16_t)f2bf(p.in[I_ABWIN][(size_t)k * 6152 + 5120 + r]) : (bf16_t)0;
        }
        for (int i = bid * NTHREADS + tid; i < 8256 * 64; i += nbl * NTHREADS) {
            const int L = i >> 6, d = i & 63;
            const float pos = (float)(L - 48);
            const float invf = 1.0f / powf(10000.0f, (float)d * (1.0f / 63.0f));
            const float ang = pos * invf;
            const double ad = (double)ang; const double kk = rint(ad * 0.15915494309189535); const double r = ad - kk * 6.283185307179586;
            float sn, cs; __sincosf((float)r, &sn, &cs);
            ((f32x2*)(ws + OFF_CS))[i] = (f32x2){cs, sn};
        }
    }
    SEAM(0);
    if (IN(1)) REPEAT(REP1) {
        PHASE_VARS
        Epi<0> E{Pb, 4096, 4096, Yb, 2048, nullptr, nullptr, nullptr, nullptr, nullptr};
        Epi<4> Es{nullptr, 0, 0, nullptr, 0, nullptr, nullptr, nullptr, nullptr, side};
        skinny_gemm<1>(lds, HB, DM, WA, DM, MMAIN, 1, 6144 / 32, E, bid, nb, tid);
        skinny_gemm<4>(lds, HB, DM, WSM, DM, 0, MROWS / 16, 1, Es, bid, nb, tid);
        pg8::Gemm g{HB, WA, MMAIN, 6144, DM}; pg8::StaticOrder S; S.init(MMAIN, 6144, nb, bid);
#ifndef NO_GEMM
        pg8::gemm_phase(lds, g, S, E, tid, xb);
#endif
    }
    SEAM(1);
#ifndef NO_TINV
    if (IN(2)) {
        { PHASE_VARS halo_save(Pb, 4096, 2048, 256, HB, tid); }
        GSYNC();
        { PHASE_VARS conv_inplace<0>(Pb, 4096, 2048, 256, HB, p, tid); rope_inplace(Pb, ws, tid); }
        GSYNC();
        REPEAT(REP2) { PHASE_VARS tinv_phase(lds, p, ws, tid); }
    }
#endif
    SEAM(2);
    if (IN(3)) REPEAT(REP3) {
        PHASE_VARS
        float* RQ = (float*)(ws + OFF_HB); float* GQ = RQ + 8 * 10 * 32768; float* GP = GQ + 8 * 10 * 32768;
        for (int u = bid; u < 240; u += nb) {
            const int kind = u / 80, r = u % 80, unit = r / 10, seg = r % 10, b = unit >> 2, h = unit & 3, c0 = seg * SEG0, c1 = c0 + SEG0;
            if (kind == 0) { int tid2 = tid; asm volatile("" : "+v"(tid2)); scan_unit<0, 1, 2>(lds, p, ws, b, h, c0, c1, nullptr, RQ + (size_t)(unit * 10 + seg) * 32768, nullptr, tid2); }
            else if (kind == 1) { int tid2 = tid; asm volatile("" : "+v"(tid2)); scan_unit<1, 1, 2>(lds, p, ws, b, h, c0, c1, nullptr, GQ + (size_t)(unit * 10 + seg) * 32768, nullptr, tid2); }
            else { int tid2 = tid; asm volatile("" : "+v"(tid2)); scan_unit<3, 1, 1>(lds, p, ws, b, h, c0, c1, nullptr, GP + (size_t)(unit * 10 + seg) * 16384, nullptr, tid2); }
        }
    }
    SEAM(3);
    if (IN(4)) {
        PHASE_VARS
        float* RQ = (float*)(ws + OFF_HB); float* GQ = RQ + 8 * 10 * 32768; float* GP = GQ + 8 * 10 * 32768;
        if (bid < 16) gdn_chain(lds, GQ + (size_t)(bid >> 1) * 10 * 32768, GP + (size_t)(bid >> 1) * 10 * 16384, bid & 1, tid);
        else {
            for (int e = (bid - 16) * NTHREADS + tid; e < 8 * 32768 / 4; e += (nbl - 16) * NTHREADS) {
                const int unit = e >> 13, off = (e & 8191) * 4;
                const float d = __expf(log1pf(-exp2f(-5.f - (float)(unit & 3))) * (64.f * SEG0));
                float* q = RQ + (size_t)unit * 10 * 32768 + off;
                f32x4 qv[NSEG0 - 1];
#pragma unroll
                for (int j = 0; j < NSEG0 - 1; ++j) qv[j] = *(const f32x4*)(q + (size_t)j * 32768);
                f32x4 S = {0.f, 0.f, 0.f, 0.f};
#pragma unroll
                for (int j = 0; j < NSEG0 - 1; ++j) { S = S * d + qv[j]; *(f32x4*)(q + (size_t)j * 32768) = S; }
            }
        }
    }
    SEAM(4);
    if (IN(5)) {
        PHASE_VARS
        float* RQ = (float*)(ws + OFF_HB); float* GQ = RQ + 8 * 10 * 32768;
        for (int u = bid; u < 256; u += nb) {
            if (u < 88) {
                const int unit = u / NSEG0, seg = u % NSEG0, b = unit >> 2, h = unit & 3, c0 = seg * SEG0, c1 = (c0 + SEG0 < NCHUNK) ? c0 + SEG0 : NCHUNK;
                int tid2 = tid; asm volatile("" : "+v"(tid2));
                scan_unit<0, 0, 2, false, true, true>(lds, p, ws, b, h, c0, c1, seg > 0 ? RQ + (size_t)(unit * 10 + seg - 1) * 32768 : nullptr, nullptr, nullptr, tid2);
            } else {
                int unit, seg, c0, c1, cfull;
                if (u < 248) { const int idx = (u - 88) % 80, half = (u - 88) / 80; unit = idx / 10; seg = idx % 10; c0 = seg * SEG0; c1 = half ? c0 + SEG0 : c0 + SEG0 / 2; cfull = half ? c0 + SEG0 / 2 : c0; }
                else { unit = u - 248; seg = 10; c0 = seg * SEG0; c1 = NCHUNK; cfull = c0; }
                int tid2 = tid; asm volatile("" : "+v"(tid2));
                scan_unit<1, 0, 2, true, true, false>(lds, p, ws, unit >> 2, unit & 3, c0, c1, seg > 0 ? GQ + (size_t)(unit * 10 + seg - 1) * 32768 : nullptr, nullptr, nullptr, tid2, cfull);
            }
        }
    }
    SEAM(5);
    if (IN(6)) {
        PHASE_VARS
        {
            const TSeg segs[2] = {{p.in[I_W1], DFF, 0, DFF, DM, W1t, 0}, {p.in[I_W2], DM, 0, DM, DFF, W2t, 0}};
            transpose_segs<2>(lds, segs, tid);
        }
        __syncthreads();
        Epi<2> Et{nullptr, 0, 0, nullptr, 0, Rm, Rt, p.in[I_X], p.in[I_META], nullptr};
        skinny_gemm<1>(lds, Yb, 2048, WO, 2048, MMAIN, 1, DM / 32, Et, bid, nb, tid);
        EpiLN<0, true> E{Rm, p.in[I_X], p.in[I_LN1W], p.in[I_LN1B], HB, lnstats};
        pg8::Gemm g{Yb, WO, MMAIN, DM, 2048}; pg8::StaticOrder S; S.init(MMAIN, DM, nb, bid);
        pg8::gemm_phase(lds, g, S, E, tid, xb);
        if (bid < 16 && tid < 64) ln_tail_row(Rt + (size_t)bid * DM, p.in[I_LN1W], p.in[I_LN1B], HB + (size_t)(MMAIN + bid) * DM, tid);
    }
    SEAM(6);
#pragma unroll
    for (int layer = 0; layer < 2; ++layer) {
        const int pb = layer == 0 ? 7 : 17;
        if (IN(pb + 1)) {
            PHASE_VARS
            Epi<1> E{Pb, DFF, 0, nullptr, 0, nullptr, nullptr, nullptr, nullptr, nullptr};
            skinny_gemm<1>(lds, HB, DM, W1t, DM, MMAIN, 1, DFF / 32, E, bid, nb, tid);
            pg8::Gemm g{HB, W1t, MMAIN, DFF, DM}; pg8::StaticOrder S; S.init(MMAIN, DFF, nb, bid);
            pg8::gemm_phase(lds, g, S, E, tid, xb);
        }
        SEAM(pb + 1);
        if (IN(pb + 2)) {
            PHASE_VARS
            pg8::Gemm g{Pb, W2t, MMAIN, DM, DFF}; pg8::StaticOrder S; S.init(MMAIN, DM, nb, bid);
            if (layer == 0) {
                Epi<3> Et{nullptr, 0, 0, nullptr, 0, Rm, Rt, nullptr, nullptr, nullptr};
                skinny_gemm<1>(lds, Pb, DFF, W2t, DFF, MMAIN, 1, DM / 32, Et, bid, nb, tid);
                EpiLN<1, true> E{Rm, nullptr, p.in[I_LN2W], p.in[I_LN2B], HB, lnstats};
                pg8::gemm_phase(lds, g, S, E, tid, xb);
                if (bid < 16 && tid < 64) ln_tail_row(Rt + (size_t)bid * DM, p.in[I_LN2W], p.in[I_LN2B], HB + (size_t)(MMAIN + bid) * DM, tid);
                {
                    __syncthreads();
                    int tid3 = tid; asm volatile("" : "+v"(tid3));
                    const float* w = p.in[I_CWIN];
                    const TSeg segs[3] = {{w, 5152, 2048, 3072, 1024, WA, 0}, {w, 5152, 0, 2048, 1024, WA, 3072}, {p.in[I_CWOUT], 1024, 0, 1024, 2048, WO, 0}};
                    transpose_segs<3>(lds, segs, tid3);
                    for (int i = bid * NTHREADS + tid3; i < 32 * 1024; i += nbl * NTHREADS) { const int r = i >> 10, k = i & 1023; WSM[i] = (bf16_t)f2bf(w[(size_t)k * 5152 + 5120 + r]); }
                }
            } else {
                EpiLN<1, false> E{Rm, nullptr, p.in[I_LN2W] + DM, p.in[I_LN2B] + DM, HB, lnstats};
                pg8::gemm_phase(lds, g, S, E, tid, xb);
            }
        }
        SEAM(pb + 2);
        if (layer == 0) {
            if (IN(11)) REPEAT(REP11) {
                PHASE_VARS
                Epi<0> E{Pb, 3072, 3072, Yb, 2048, nullptr, nullptr, nullptr, nullptr, nullptr};
                Epi<4> Es{nullptr, 0, 0, nullptr, 0, nullptr, nullptr, nullptr, nullptr, side};
                skinny_gemm<1>(lds, HB, DM, WA, DM, MMAIN, 1, 5120 / 32, E, bid, nb, tid);
                skinny_gemm<4>(lds, HB, DM, WSM, DM, 0, MROWS / 16, 1, Es, bid, nb, tid);
                pg8::Gemm g{HB, WA, MMAIN, 5120, DM}; pg8::StaticOrder S; S.init(MMAIN, 5120, nb, bid);
                pg8::gemm_phase(lds, g, S, E, tid, xb);
            }
            SEAM(11);
            if (IN(12)) {
                { PHASE_VARS halo_save(Pb, 3072, 0, 384, HB, tid); }
                GSYNC();
                { PHASE_VARS conv_inplace<1>(Pb, 3072, 0, 384, HB, p, tid); }
                GSYNC();
            }
            if (IN(12)) REPEAT(REP12) {
                PHASE_VARS
                float* SQ = (float*)(ws + OFF_HB); float* SG = SQ + (size_t)16 * 14 * 32768;
                for (int u = bid; u < 224; u += nb) {
                    const int unit = u / 14, seg = u % 14, c0 = seg * SEG1;
                    int tid2 = tid; asm volatile("" : "+v"(tid2));
                    scan_unit<2, 1, 2>(lds, p, ws, unit >> 3, unit & 7, c0, c0 + SEG1, nullptr, SQ + (size_t)(unit * 14 + seg) * 32768, SG + (unit * 14 + seg) * 4, tid2);
                }
            }
            SEAM(12);
            if (IN(13)) {
                PHASE_VARS
                float* SQ = (float*)(ws + OFF_HB); float* SG = SQ + (size_t)16 * 14 * 32768;
                for (int e = bid * NTHREADS + tid; e < 16 * 32768 / 4; e += nbl * NTHREADS) {
                    const int unit = e >> 13, off = (e & 8191) * 4, hq = (e & 8191) >> 11;
                    float* q = SQ + (size_t)unit * 14 * 32768 + off;
                    f32x4 qv[NSEG1 - 1]; float dg[NSEG1 - 1];
#pragma unroll
                    for (int j = 0; j < NSEG1 - 1; ++j) { qv[j] = *(const f32x4*)(q + (size_t)j * 32768); dg[j] = SG[(unit * 14 + j) * 4 + hq]; }
                    f32x4 S = {0.f, 0.f, 0.f, 0.f};
#pragma unroll
                    for (int j = 0; j < NSEG1 - 1; ++j) { S = S * __expf(dg[j]) + qv[j]; *(f32x4*)(q + (size_t)j * 32768) = S; }
                }
            }
            SEAM(13);
            if (IN(14)) {
                PHASE_VARS
                float* SQ = (float*)(ws + OFF_HB);
                for (int u = bid; u < 240; u += nb) {
                    const int unit = u / NSEG1, seg = u % NSEG1, c0 = seg * SEG1, c1 = (c0 + SEG1 < NCHUNK) ? c0 + SEG1 : NCHUNK;
                    int tid2 = tid; asm volatile("" : "+v"(tid2));
                    scan_unit<2, 0, 2>(lds, p, ws, unit >> 3, unit & 7, c0, c1, seg > 0 ? SQ + (size_t)(unit * 14 + seg - 1) * 32768 : nullptr, nullptr, nullptr, tid2);
                }
            }
            SEAM(14);
            if (IN(15)) { PHASE_VARS rmsnorm_phase(Yb, p.in[I_CNORMW], tid); }
            SEAM(15);
            if (IN(16)) {
                PHASE_VARS
                {
                    const TSeg segs[2] = {{p.in[I_W1] + (size_t)DM * DFF, DFF, 0, DFF, DM, W1t, 0}, {p.in[I_W2] + (size_t)DM * DFF, DM, 0, DM, DFF, W2t, 0}};
                    transpose_segs<2>(lds, segs, tid);
                }
                __syncthreads();
                Epi<3> Et{nullptr, 0, 0, nullptr, 0, Rm, Rt, nullptr, nullptr, nullptr};
                skinny_gemm<1>(lds, Yb, 2048, WO, 2048, MMAIN, 1, DM / 32, Et, bid, nb, tid);
                EpiLN<1, true> E{Rm, nullptr, p.in[I_LN1W] + DM, p.in[I_LN1B] + DM, HB, lnstats};
                pg8::Gemm g{Yb, WO, MMAIN, DM, 2048}; pg8::StaticOrder S; S.init(MMAIN, DM, nb, bid);
                pg8::gemm_phase(lds, g, S, E, tid, xb);
                if (bid < 16 && tid < 64) ln_tail_row(Rt + (size_t)bid * DM, p.in[I_LN1W] + DM, p.in[I_LN1B] + DM, HB + (size_t)(MMAIN + bid) * DM, tid);
            }
            SEAM(16);
        }
    }
#undef IN
#undef SEAM
}

#ifndef MK_PER_PHASE
#define MK_PER_PHASE 0
#endif
extern "C" void kernel_launch(void* const* d_in, const int* in_sizes, int n_in, void* d_out, int out_size, void* d_ws, size_t ws_size, hipStream_t stream) {
    static int grid = 0;
    if (grid == 0) {
        if (n_in != 25 || ws_size < WS_END || out_size != MMAIN * DM) { fprintf(stderr, "kernel_launch: unexpected shapes (n_in %d ws %zu out %d)\n", n_in, ws_size, out_size); grid = -1; return; }
        int dev = 0, cus = 0, per_cu = 0;
        hipGetDevice(&dev);
        hipDeviceGetAttribute(&cus, hipDeviceAttributeMultiprocessorCount, dev);
        if (hipFuncSetAttribute((const void*)mega_fwd, hipFuncAttributeMaxDynamicSharedMemorySize, LDS_BYTES) != hipSuccess) { fprintf(stderr, "kernel_launch: hipFuncSetAttribute failed\n"); grid = -1; return; }
        if (hipOccupancyMaxActiveBlocksPerMultiprocessor(&per_cu, (const void*)mega_fwd, NTHREADS, LDS_BYTES) != hipSuccess || per_cu < 1) { fprintf(stderr, "kernel_launch: occupancy query says %d\n", per_cu); grid = -1; return; }
        grid = cus * (per_cu > 1 ? 1 : per_cu);
        fprintf(stderr, "kernel_launch: grid %d (cus %d per_cu %d)\n", grid, cus, per_cu);
    }
    if (grid < 0) return;
    if (hipMemsetAsync((char*)d_ws + OFF_BAR, 0, 16384, stream) != hipSuccess) { fprintf(stderr, "kernel_launch: memset failed\n"); return; }
    Params p{};
    for (int i = 0; i < 25; ++i) p.in[i] = (const float*)d_in[i];
    p.out = (float*)d_out; p.ws = (uchar*)d_ws;
#if MK_PER_PHASE
    for (int ph = 0; ph < 21; ++ph) {
        p.ph_lo = ph; p.ph_hi = ph + 1;
        void* args[] = {&p};
        hipError_t e = hipLaunchCooperativeKernel((const void*)mega_fwd, dim3(grid), dim3(NTHREADS), args, LDS_BYTES, stream);
        if (e != hipSuccess) { fprintf(stderr, "cooperative launch failed: %s\n", hipGetErrorString(e)); break; }
    }
#else
    p.ph_lo = 0; p.ph_hi = 20;
    void* args[] = {&p};
    hipError_t e = hipLaunchCooperativeKernel((const void*)mega_fwd, dim3(grid), dim3(NTHREADS), args, LDS_BYTES, stream);
    if (e != hipSuccess) fprintf(stderr, "cooperative launch failed: %s (grid %d)\n", hipGetErrorString(e), grid);
#endif
}
```
